# Optimizing an MI355X kernel written in HIP

```python
import jax, jax.numpy as jnp
from jax import lax
import numpy as np

D_MODEL = 1024
BATCH = 4
SEQ = 4096
DEPTH = 4
DEC_BATCH = 32
DEC_SEQ = 4
PAST_LEN = 8192
PAGE_SIZE = 128

N_A_LAYERS = DEPTH // 2
N_B_LAYERS = DEPTH - N_A_LAYERS
CHUNK = 128
A_WIDTH = 3 * D_MODEL // 4
A_GROUPS = 4
A_GROUP_DIM = A_WIDTH // A_GROUPS
MEM_TOKENS = 256
MEM_HEADS = 4
MEM_HEAD_DIM = 64
MEM_WIDTH = MEM_HEADS * MEM_HEAD_DIM
HEAD_DIM = 64
NSA_HEADS = A_WIDTH // HEAD_DIM
NSA_KV_HEADS = 4
GQA_GROUP = NSA_HEADS // NSA_KV_HEADS
NSA_WIDTH = NSA_HEADS * HEAD_DIM
KV_WIDTH = NSA_KV_HEADS * HEAD_DIM
N_BRANCH = 3
CMP_BLOCK = 32
CMP_STRIDE = 16
CMP_RATIO = CMP_BLOCK // CMP_STRIDE
CMP_HIDDEN = 2 * HEAD_DIM
SEL_BLOCK = 64
SEL_TOPK = 16
WINDOW = 512
SEL_Q_BLOCK = 32
ROPE_THETA = 500000.0
ROPE_DIM = HEAD_DIM // 4
D_FF = 4 * D_MODEL
DEEPNORM_ALPHA = (2.0 * DEPTH) ** 0.25
DEEPNORM_BETA = (8.0 * DEPTH) ** -0.25
LN_EPS = 1e-5
NEG = -1e30
FORCE_BONUS = 1e4

kernel_name = "yoco_gmlp_nsa_memory_decoder_step"


def layer_norm(x, g, b):
    xf = x.astype(jnp.float32)
    mu = xf.mean(-1, keepdims=True)
    var = jnp.square(xf - mu).mean(-1, keepdims=True)
    return ((xf - mu) * lax.rsqrt(var + LN_EPS) * g.astype(jnp.float32) + b.astype(jnp.float32)).astype(x.dtype)


def rope(x, pos):
    half = ROPE_DIM // 2
    inv_freq = ROPE_THETA ** (-jnp.arange(half, dtype=jnp.float32) / half)
    ang = pos.astype(jnp.float32)[:, None] * inv_freq[None, :]
    ang = ang.reshape((pos.shape[0],) + (1,) * (x.ndim - 3) + (half,))
    cos, sin = jnp.cos(ang), jnp.sin(ang)
    xr = x[..., :ROPE_DIM].astype(jnp.float32)
    x1, x2 = xr[..., :half], xr[..., half:]
    rot = jnp.concatenate([x1 * cos - x2 * sin, x2 * cos + x1 * sin], axis=-1)
    return jnp.concatenate([rot.astype(x.dtype), x[..., ROPE_DIM:]], axis=-1)


def masked_softmax(s, mask):
    s = jnp.where(mask, s, NEG)
    return jnp.where(mask, jax.nn.softmax(s, axis=-1), 0.0)


def spatial_gate(u, v, w_s, b_s):
    B, T = u.shape[:2]
    n_chunk = -(-T // CHUNK)
    pad = n_chunk * CHUNK - T
    vp = jnp.pad(v, ((0, 0), (0, pad), (0, 0), (0, 0))).reshape(B, n_chunk, CHUNK, A_GROUPS, A_GROUP_DIM)
    causal = jnp.tril(jnp.ones((CHUNK, CHUNK), dtype=bool))
    w = jnp.where(causal[None], w_s, 0.0).astype(v.dtype)
    mixed = jnp.einsum('gts,bcsgd->bctgd', w, vp) + b_s.T[None, None, :, :, None]
    mixed = mixed.reshape(B, n_chunk * CHUNK, A_GROUPS, A_GROUP_DIM)[:, :T]
    return u * mixed


def mem_attend(q, mem_kv):
    s = jnp.einsum('bthd,bmhd->bhtm', q, mem_kv[:, :, 0]).astype(jnp.float32) * (MEM_HEAD_DIM ** -0.5)
    p = jax.nn.softmax(s, axis=-1).astype(q.dtype)
    return jnp.einsum('bhtm,bmhd->bthd', p, mem_kv[:, :, 1])


def sq_relu_mlp(x, w_up, w_down):
    return jnp.square(jax.nn.relu(x @ w_up)) @ w_down


def mixer_a(x, mem_kv, w_in, ln_g, ln_b, w_s, b_s, w_out):
    B, T = x.shape[:2]
    proj = x @ w_in
    uv = jax.nn.gelu(proj[..., :2 * A_WIDTH])
    u = uv[..., :A_WIDTH]
    v = layer_norm(uv[..., A_WIDTH:], ln_g, ln_b)
    mixed = spatial_gate(u.reshape(B, T, A_GROUPS, A_GROUP_DIM), v.reshape(B, T, A_GROUPS, A_GROUP_DIM), w_s, b_s)
    q_mem = proj[..., 2 * A_WIDTH:].reshape(B, T, MEM_HEADS, MEM_HEAD_DIM)
    o_mem = mem_attend(q_mem, mem_kv).reshape(B, T, MEM_WIDTH)
    return jnp.concatenate([mixed.reshape(B, T, A_WIDTH), o_mem], axis=-1) @ w_out, v


def mixer_b(x, pos, mem_kv, attend, w_in, w_out):
    B, T = x.shape[:2]
    proj = x @ w_in
    q = rope(proj[..., :NSA_WIDTH].reshape(B, T, NSA_HEADS, HEAD_DIM), pos)
    gates = jax.nn.sigmoid(proj[..., NSA_WIDTH:NSA_WIDTH + N_BRANCH * NSA_HEADS].reshape(B, T, NSA_HEADS, N_BRANCH))
    q_mem = proj[..., NSA_WIDTH + N_BRANCH * NSA_HEADS:].reshape(B, T, MEM_HEADS, MEM_HEAD_DIM)
    o_nsa = attend(q, gates)
    o_mem = mem_attend(q_mem, mem_kv).reshape(B, T, MEM_WIDTH)
    return jnp.concatenate([o_nsa, o_mem], axis=-1) @ w_out


def shared_rows(h, pos, w_kv_shared):
    B, T = h.shape[:2]
    kv = (h @ w_kv_shared).reshape(B, T, N_BRANCH, 2, NSA_KV_HEADS, HEAD_DIM)
    k = rope(kv[:, :, :, 0], pos)
    return jnp.stack([k, kv[:, :, :, 1]], axis=3)


def compress(rows, cmp_pe, w_phi1, w_phi2):
    B, L = rows.shape[:2]
    n_str = -(-L // CMP_STRIDE)
    x = jnp.pad(rows, ((0, 0), (0, n_str * CMP_STRIDE - L), (0, 0), (0, 0), (0, 0)))
    x = x.reshape(B, n_str, CMP_STRIDE, 2, NSA_KV_HEADS, HEAD_DIM)
    n_cmp = n_str - CMP_RATIO + 1
    w1 = w_phi1.reshape(CMP_RATIO, CMP_STRIDE, 2, HEAD_DIM, CMP_HIDDEN)
    h = jnp.einsum('lcd,lcde->ce', cmp_pe, w_phi1)[:, None, :]
    for j in range(CMP_RATIO):
        h = h + jnp.einsum('bnschd,scde->bnche', x, w1[j])[:, j:j + n_cmp]
    return jnp.einsum('bnche,ced->bnchd', jax.nn.gelu(h), w_phi2)


def to_sel_blocks(rows):
    B, L = rows.shape[:2]
    n_slc = -(-L // SEL_BLOCK)
    x = jnp.pad(rows, ((0, 0), (0, n_slc * SEL_BLOCK - L), (0, 0), (0, 0), (0, 0)))
    return x.reshape(B, n_slc, SEL_BLOCK, 2, NSA_KV_HEADS, HEAD_DIM)


def nsa_query_block(q, gates, t_pos, kv_cmp, slc_blocks, win_kv, win_pos):
    B, Q = q.shape[:2]
    dt = q.dtype
    scale = HEAD_DIM ** -0.5
    qg = q.reshape(B, Q, NSA_KV_HEADS, GQA_GROUP, HEAD_DIM)
    n_cmp = kv_cmp.shape[1]
    cmp_start = jnp.arange(n_cmp) * CMP_STRIDE
    m_cmp = (cmp_start + CMP_BLOCK - 1)[None, :] <= t_pos[:, None]
    s_cmp = jnp.einsum('bqgrd,bngd->bgrqn', qg, kv_cmp[:, :, 0]).astype(jnp.float32) * scale
    p_cmp = masked_softmax(s_cmp, m_cmp)
    o_cmp = jnp.einsum('bgrqn,bngd->bqgrd', p_cmp.astype(dt), kv_cmp[:, :, 1])
    n_slc = slc_blocks.shape[1]
    sel_start = jnp.arange(n_slc) * SEL_BLOCK
    overlap = ((cmp_start[:, None] < sel_start[None, :] + SEL_BLOCK)
               & (cmp_start[:, None] + CMP_BLOCK > sel_start[None, :])).astype(jnp.float32)
    imp = jnp.einsum('bgrqn,nj->bgqj', p_cmp, overlap)
    blk = jnp.arange(n_slc)[None, :]
    cur = (t_pos // SEL_BLOCK)[:, None]
    forced = (blk == 0) | (blk == cur) | (blk == cur - 1)
    causal = sel_start[None, :] <= t_pos[:, None]
    score = jnp.where(causal, imp + FORCE_BONUS * forced.astype(jnp.float32), NEG)
    n_top = min(SEL_TOPK, n_slc)
    top_val, top_idx = lax.top_k(score, n_top)
    bi = jnp.arange(B)[:, None, None, None]
    gi = jnp.arange(NSA_KV_HEADS)[None, :, None, None]
    sel = slc_blocks[bi, top_idx, :, :, gi, :]
    sel = sel.reshape(B, NSA_KV_HEADS, Q, n_top * SEL_BLOCK, 2, HEAD_DIM)
    k_pos = top_idx[..., None] * SEL_BLOCK + jnp.arange(SEL_BLOCK)
    m_sel = ((top_val > NEG / 2)[..., None] & (k_pos <= t_pos[None, None, :, None, None]))
    m_sel = m_sel.reshape(B, NSA_KV_HEADS, 1, Q, n_top * SEL_BLOCK)
    s_sel = jnp.einsum('bqgrd,bgqkd->bgrqk', qg, sel[..., 0, :]).astype(jnp.float32) * scale
    p_sel = masked_softmax(s_sel, m_sel)
    o_sel = jnp.einsum('bgrqk,bgqkd->bqgrd', p_sel.astype(dt), sel[..., 1, :])
    diff = t_pos[:, None] - win_pos[None, :]
    m_win = (diff >= 0) & (diff < WINDOW) & (win_pos[None, :] >= 0)
    s_win = jnp.einsum('bqgrd,bkgd->bgrqk', qg, win_kv[:, :, 0]).astype(jnp.float32) * scale
    p_win = masked_softmax(s_win, m_win)
    o_win = jnp.einsum('bgrqk,bkgd->bqgrd', p_win.astype(dt), win_kv[:, :, 1])
    g = gates.reshape(B, Q, NSA_KV_HEADS, GQA_GROUP, N_BRANCH, 1)
    o = g[..., 0, :] * o_cmp + g[..., 1, :] * o_sel + g[..., 2, :] * o_win
    return o.reshape(B, Q, NSA_WIDTH)


def run_trunk(x, pos, mem_kv, nsa_context, p):
    v_rows = []
    attend, nsa_state = None, None
    for l in range(DEPTH):
        if l < N_A_LAYERS:
            mix, v = mixer_a(x, mem_kv[l], p["w_in_a"][l], p["ln_v_g"][l], p["ln_v_b"][l],
                             p["w_spatial"][l], p["b_spatial"][l], p["w_out_a"][l])
            v_rows.append(v)
        else:
            if l == N_A_LAYERS:
                attend, nsa_state = nsa_context(x)
            i = l - N_A_LAYERS
            mix = mixer_b(x, pos, mem_kv[l], attend, p["w_in_b"][i], p["w_out_b"][i])
        x = layer_norm(DEEPNORM_ALPHA * x + mix, p["ln1_g"][l], p["ln1_b"][l])
        x = layer_norm(DEEPNORM_ALPHA * x + sq_relu_mlp(x, p["w_up"][l], p["w_down"][l]), p["ln2_g"][l], p["ln2_b"][l])
    return x, jnp.stack(v_rows), nsa_state


def setup_inputs(seed: int = 0) -> dict:
    key = jax.random.key(seed)
    ks = iter(jax.random.split(key, 40))

    def nrm(shape, scale):
        return jax.random.normal(next(ks), shape, jnp.float32) * scale

    n_pages = PAST_LEN // PAGE_SIZE
    n_used = DEC_BATCH * n_pages
    n_pool = n_used + max(1, n_used // 4)
    page_table = jax.random.permutation(next(ks), n_pool)[:n_used].reshape(DEC_BATCH, n_pages).astype(jnp.int32)
    win_buf = min(WINDOW, PAST_LEN)
    a_in = 2 * A_WIDTH + MEM_WIDTH
    b_in = NSA_WIDTH + N_BRANCH * NSA_HEADS + MEM_WIDTH
    return {
        "x_prompt": nrm((BATCH, SEQ, D_MODEL), 1.0),
        "x_sample": nrm((DEC_BATCH, DEC_SEQ, D_MODEL), 1.0),
        "cache_cmp_kv": nrm((n_pool, PAGE_SIZE, 2, NSA_KV_HEADS, HEAD_DIM), 1.0),
        "cache_slc_kv": nrm((n_pool, PAGE_SIZE, 2, NSA_KV_HEADS, HEAD_DIM), 1.0),
        "cache_win_kv": nrm((DEC_BATCH, win_buf, 2, NSA_KV_HEADS, HEAD_DIM), 1.0),
        "cache_mem_kv": nrm((DEPTH, DEC_BATCH, MEM_TOKENS, 2, MEM_HEADS, MEM_HEAD_DIM), 1.0),
        "page_table": page_table,
        "mem_prompt": nrm((BATCH, MEM_TOKENS, D_MODEL), 1.0),
        "w_in_a": nrm((N_A_LAYERS, D_MODEL, a_in), D_MODEL ** -0.5),
        "ln_v_g": 1.0 + nrm((N_A_LAYERS, A_WIDTH), 0.05),
        "ln_v_b": nrm((N_A_LAYERS, A_WIDTH), 0.02),
        "w_spatial": nrm((N_A_LAYERS, A_GROUPS, CHUNK, CHUNK), CHUNK ** -0.5),
        "b_spatial": 1.0 + nrm((N_A_LAYERS, A_GROUPS, CHUNK), 0.1),
        "w_out_a": nrm((N_A_LAYERS, A_WIDTH + MEM_WIDTH, D_MODEL), (A_WIDTH + MEM_WIDTH) ** -0.5 * DEEPNORM_BETA),
        "w_in_b": nrm((N_B_LAYERS, D_MODEL, b_in), D_MODEL ** -0.5),
        "w_out_b": nrm((N_B_LAYERS, NSA_WIDTH + MEM_WIDTH, D_MODEL), (NSA_WIDTH + MEM_WIDTH) ** -0.5 * DEEPNORM_BETA),
        "w_kv_shared": nrm((D_MODEL, N_BRANCH * 2 * KV_WIDTH), D_MODEL ** -0.5),
        "cmp_pe": nrm((CMP_BLOCK, 2, HEAD_DIM), 0.1),
        "w_phi1": nrm((CMP_BLOCK, 2, HEAD_DIM, CMP_HIDDEN), (CMP_BLOCK * HEAD_DIM) ** -0.5),
        "w_phi2": nrm((2, CMP_HIDDEN, HEAD_DIM), CMP_HIDDEN ** -0.5),
        "w_mem_kv": nrm((DEPTH, D_MODEL, 2 * MEM_WIDTH), D_MODEL ** -0.5),
        "ln1_g": 1.0 + nrm((DEPTH, D_MODEL), 0.05),
        "ln1_b": nrm((DEPTH, D_MODEL), 0.02),
        "ln2_g": 1.0 + nrm((DEPTH, D_MODEL), 0.05),
        "ln2_b": nrm((DEPTH, D_MODEL), 0.02),
        "w_up": nrm((DEPTH, D_MODEL, D_FF), D_MODEL ** -0.5),
        "w_down": nrm((DEPTH, D_FF, D_MODEL), D_FF ** -0.5 * DEEPNORM_BETA),
    }


def reference(x_prompt, x_sample, cache_cmp_kv, cache_slc_kv, cache_win_kv, cache_mem_kv, page_table, mem_prompt,
              w_in_a, ln_v_g, ln_v_b, w_spatial, b_spatial, w_out_a, w_in_b, w_out_b, w_kv_shared, cmp_pe,
              w_phi1, w_phi2, w_mem_kv, ln1_g, ln1_b, ln2_g, ln2_b, w_up, w_down):
    p = {"w_in_a": w_in_a, "ln_v_g": ln_v_g, "ln_v_b": ln_v_b, "w_spatial": w_spatial, "b_spatial": b_spatial,
         "w_out_a": w_out_a, "w_in_b": w_in_b, "w_out_b": w_out_b, "ln1_g": ln1_g, "ln1_b": ln1_b,
         "ln2_g": ln2_g, "ln2_b": ln2_b, "w_up": w_up, "w_down": w_down}

    Bp, S = x_prompt.shape[:2]
    pos_p = jnp.arange(S, dtype=jnp.int32)
    mem_kv_prompt = jnp.einsum('bmd,lde->lbme', mem_prompt, w_mem_kv).reshape(
        DEPTH, Bp, MEM_TOKENS, 2, MEM_HEADS, MEM_HEAD_DIM)

    def prompt_ctx(h):
        rows = shared_rows(h, pos_p, w_kv_shared)
        cmp_rows, slc_rows, win_rows = rows[:, :, 0], rows[:, :, 1], rows[:, :, 2]
        kv_cmp = compress(cmp_rows, cmp_pe, w_phi1, w_phi2)
        slc_blocks = to_sel_blocks(slc_rows)
        win_pad = jnp.pad(win_rows, ((0, 0), (WINDOW, 0), (0, 0), (0, 0), (0, 0)))

        def attend(q, gates):
            n_blk = S // SEL_Q_BLOCK
            qb = q.reshape(Bp, n_blk, SEL_Q_BLOCK, NSA_HEADS, HEAD_DIM).swapaxes(0, 1)
            gb = gates.reshape(Bp, n_blk, SEL_Q_BLOCK, NSA_HEADS, N_BRANCH).swapaxes(0, 1)

            def body(args):
                c, qc, gc = args
                t0 = c * SEL_Q_BLOCK
                t_pos = t0 + jnp.arange(SEL_Q_BLOCK, dtype=jnp.int32)
                win = lax.dynamic_slice_in_dim(win_pad, t0, WINDOW + SEL_Q_BLOCK, axis=1)
                win_pos = t0 - WINDOW + jnp.arange(WINDOW + SEL_Q_BLOCK, dtype=jnp.int32)
                return nsa_query_block(qc, gc, t_pos, kv_cmp, slc_blocks, win, win_pos)

            out = lax.map(body, (jnp.arange(n_blk, dtype=jnp.int32), qb, gb))
            return out.swapaxes(0, 1).reshape(Bp, S, NSA_WIDTH)

        return attend, (cmp_rows, slc_rows, win_rows[:, S - min(WINDOW, S):])

    y_prompt, _, (cmp_kv_prompt, slc_kv_prompt, win_kv_prompt) = run_trunk(
        x_prompt, pos_p, mem_kv_prompt, prompt_ctx, p)

    Bs, T = x_sample.shape[:2]
    past_len = page_table.shape[1] * PAGE_SIZE
    pos_s = past_len + jnp.arange(T, dtype=jnp.int32)
    n_buf = cache_win_kv.shape[1]

    def sample_ctx(h):
        rows = shared_rows(h, pos_s, w_kv_shared)
        new_cmp, new_slc, new_win = rows[:, :, 0], rows[:, :, 1], rows[:, :, 2]
        past_cmp = cache_cmp_kv[page_table].reshape(Bs, past_len, 2, NSA_KV_HEADS, HEAD_DIM)
        past_slc = cache_slc_kv[page_table].reshape(Bs, past_len, 2, NSA_KV_HEADS, HEAD_DIM)
        kv_cmp = compress(jnp.concatenate([past_cmp, new_cmp], axis=1), cmp_pe, w_phi1, w_phi2)
        slc_blocks = to_sel_blocks(jnp.concatenate([past_slc, new_slc], axis=1))
        win_all = jnp.concatenate([cache_win_kv, new_win], axis=1)
        win_pos = past_len - n_buf + jnp.arange(n_buf + T, dtype=jnp.int32)

        def attend(q, gates):
            return nsa_query_block(q, gates, pos_s, kv_cmp, slc_blocks, win_all, win_pos)

        return attend, (new_cmp, new_slc, win_all[:, T:])

    y_sample, gmlp_v_sample, (cmp_kv_sample, slc_kv_sample, win_kv_sample) = run_trunk(
        x_sample, pos_s, cache_mem_kv, sample_ctx, p)

    return (y_prompt, y_sample, cmp_kv_prompt, slc_kv_prompt, win_kv_prompt, mem_kv_prompt,
            cmp_kv_sample, slc_kv_sample, win_kv_sample, gmlp_v_sample)
```

```cpp
#include <hip/hip_runtime.h>
#include <cstdio>
#include <cstdint>

#define LAS __attribute__((address_space(3)))
typedef unsigned short bf16;
typedef short bf16x8 __attribute__((ext_vector_type(8)));
typedef float f32x4 __attribute__((ext_vector_type(4)));
typedef float f32x2 __attribute__((ext_vector_type(2)));
typedef unsigned u32x4 __attribute__((ext_vector_type(4)));
typedef unsigned u32x2 __attribute__((ext_vector_type(2)));
typedef __bf16 bf16x2_t __attribute__((ext_vector_type(2)));

constexpr int D = 1024, BP = 4, SP = 4096, MP = BP * SP, BS = 32, TS = 4, MS = BS * TS, MT = MP + MS;
constexpr int AW = 768, MW = 256, NIA = 1792, NIB = 1060, NIBP = 1280, NKV = 1536, FF = 4096;
constexpr int PAST = 8192, NPG = 64;
constexpr float ALPHA = 1.6817928305074292f;
constexpr float LN_EPS = 1e-5f;
constexpr float QSC = 0.125f * 1.4426950408889634f;
constexpr float NEG_INF = -__builtin_inff();

__device__ __forceinline__ unsigned pk2(float lo, float hi) { f32x2 v = {lo, hi}; bf16x2_t b = __builtin_convertvector(v, bf16x2_t); return __builtin_bit_cast(unsigned, b); }
__device__ __forceinline__ float bf2f(unsigned short h) { return __uint_as_float(((unsigned)h) << 16); }
__device__ __forceinline__ u32x2 pk4(f32x4 v) { u32x2 r; r.x = pk2(v[0], v[1]); r.y = pk2(v[2], v[3]); return r; }
__device__ __forceinline__ bf16x8 pk8(f32x4 a, f32x4 b) { u32x4 r; r.x = pk2(a[0], a[1]); r.y = pk2(a[2], a[3]); r.z = pk2(b[0], b[1]); r.w = pk2(b[2], b[3]); return __builtin_bit_cast(bf16x8, r); }
__device__ __forceinline__ float ex2(float x) { return __builtin_amdgcn_exp2f(x); }
__device__ __forceinline__ float rcp(float x) { return __builtin_amdgcn_rcpf(x); }
__device__ __forceinline__ float gelu_t(float x) {
    const float u = 0.7978845608028654f * (x + 0.044715f * x * x * x);
    return x * rcp(1.0f + ex2(-2.0f * 1.4426950408889634f * u));
}
__device__ __forceinline__ float sigmoid_f(float x) { return rcp(1.0f + ex2(-1.4426950408889634f * x)); }
__device__ __forceinline__ float wave_sum(float v) {
#pragma unroll
    for (int o = 1; o < 64; o <<= 1) v += __shfl_xor(v, o);
    return v;
}
__device__ __forceinline__ float wave_max(float v) {
#pragma unroll
    for (int o = 1; o < 64; o <<= 1) v = fmaxf(v, __shfl_xor(v, o));
    return v;
}
#define MFMA16(a, b, c) __builtin_amdgcn_mfma_f32_16x16x32_bf16((a), (b), (c), 0, 0, 0)
#define LDS_WAIT() asm volatile("s_waitcnt lgkmcnt(0)" ::: "memory")

#define XB_TMO      128
#define XB_XCNT(j)  (256  + 64 * (j))
#define XB_XSUB(j)  (1280 + 64 * (j))
#define XB_XGEN(j)  (2304 + 64 * (j))
#define XB_TOP      3328
#define XB_TOPGEN   3392
#define XCD_BAR_WORDS 3456
#define XB_SPIN_CAP (1u << 22)
__device__ __forceinline__ unsigned xb_ld(unsigned* p)              { return __hip_atomic_load(p, __ATOMIC_RELAXED, __HIP_MEMORY_SCOPE_AGENT); }
__device__ __forceinline__ unsigned xb_add(unsigned* p, unsigned v) { return __hip_atomic_fetch_add(p, v, __ATOMIC_RELAXED, __HIP_MEMORY_SCOPE_AGENT); }
__device__ __forceinline__ unsigned xb_xcc_id() { return (unsigned)__builtin_amdgcn_s_getreg((3 << 11) | 20) & 0xFu; }
#define XB_SPIN(cond, bar) do { unsigned _sp = 0; while (cond) { __builtin_amdgcn_s_sleep(1); \
    if ((++_sp & 255u) == 0u) { if (xb_ld(&(bar)[XB_TMO])) break; if (_sp > XB_SPIN_CAP) { atomicAdd(&(bar)[XB_TMO], 1u); break; } } } } while (0)
struct XcdBarrier { unsigned* bar; unsigned x; volatile LAS unsigned* st; };
__device__ __forceinline__ XcdBarrier xcd_barrier_post(unsigned* bar, volatile LAS unsigned* st) {
    XcdBarrier b; b.bar = bar; b.x = xb_xcc_id(); b.st = st;
    if (threadIdx.x == 0) (void)xb_add(&bar[XB_XCNT(b.x)], 1u);
    return b;
}
__device__ __forceinline__ void xcd_barrier_complete(unsigned* bar, unsigned x, unsigned& nloc, unsigned& nx) {
    const unsigned G = gridDim.x * gridDim.y * gridDim.z;
    unsigned sum, cnt, mine, sp = 0u;
    for (;;) {
        sum = 0u; cnt = 0u; mine = 0u;
#pragma unroll
        for (unsigned j = 0; j < 16; ++j) { const unsigned c = xb_ld(&bar[XB_XCNT(j)]); sum += c; cnt += (c > 0u) ? 1u : 0u; mine = (j == x) ? c : mine; }
        if (sum == G) break;
        __builtin_amdgcn_s_sleep(1);
        if ((++sp & 255u) == 0u) { if (xb_ld(&bar[XB_TMO])) break; if (sp > XB_SPIN_CAP) { atomicAdd(&bar[XB_TMO], 1u); break; } }
    }
    nloc = mine > 0u ? mine : 1u; nx = cnt > 0u ? cnt : 1u;
}
__device__ __forceinline__ void xcd_barrier(const XcdBarrier& b) {
    asm volatile("s_waitcnt vmcnt(0)" ::: "memory");
    __syncthreads();
    if (threadIdx.x == 0) {
        unsigned* bar = b.bar;
        __builtin_amdgcn_s_waitcnt(0);
        unsigned nloc = b.st[0], nx = b.st[1];
        if (nloc == 0u) { xcd_barrier_complete(bar, b.x, nloc, nx); b.st[0] = nloc; b.st[1] = nx; }
        const unsigned old = xb_add(&bar[XB_XSUB(b.x)], 1u);
        const unsigned gen = old / nloc;
        if (old + 1u == (gen + 1u) * nloc) {
            __builtin_amdgcn_fence(__ATOMIC_RELEASE, "agent");
            asm volatile("s_waitcnt vmcnt(0)" ::: "memory");
            const unsigned og = xb_add(&bar[XB_TOP], 1u);
            const unsigned tg = og / nx;
            if (og + 1u == (tg + 1u) * nx) xb_add(&bar[XB_TOPGEN], 1u);
            else XB_SPIN(xb_ld(&bar[XB_TOPGEN]) == tg, bar);
            __builtin_amdgcn_fence(__ATOMIC_ACQUIRE, "agent");
            xb_add(&bar[XB_XGEN(b.x)], 1u);
            asm volatile("s_waitcnt vmcnt(0)" ::: "memory");
        } else {
            XB_SPIN(xb_ld(&bar[XB_XGEN(b.x)]) == gen, bar);
            __builtin_amdgcn_fence(__ATOMIC_ACQUIRE, "agent");
            asm volatile("s_waitcnt vmcnt(0)" ::: "memory");
        }
    }
    __syncthreads();
}

namespace pg8 {
#define PG8_LAS __attribute__((address_space(3)))
typedef unsigned short bf16_t;
constexpr int BM = 256, BK = 64, HALF = 128, HTB = HALF * BK * 2  , STAGE_BYTES = 8 * HTB, NXCD = 8, WGM = 8;

__host__ __device__ __forceinline__ int lds_byte(int r, int c) { const int st = (r >> 4) * 2 + (c >> 5), rr = r & 15, cc = c & 31, ob = rr * 64 + cc * 2; return st * 1024 + (ob ^ (((ob >> 9) & 1) << 5)); }
__host__ __device__ __forceinline__ void stage_rc(int b, int& R, int& C) { const int st = b / 1024, sb = b % 1024, swz = sb ^ (((sb >> 9) & 1) << 5); R = (st >> 1) * 16 + swz / 64; C = (st & 1) * 32 + (swz % 64) / 2; }
__host__ __device__ __forceinline__ int perm32(int rho) { const int n = rho >> 4, i = rho & 15; return 8 * (i >> 2) + 4 * n + (i & 3); }

struct Unit { int pm, pn; };
struct Gemm { const bf16_t* A; const bf16_t* Bt; int M, N, K; };

struct StaticOrder {
    int nM, nN, nwg, G, c;
    __host__ __device__ void init(int M, int N, int G_, int c_) { nM = M / BM; nN = N / BM; nwg = nM * nN; G = G_; c = c_; }
    __host__ __device__ bool next(int i, Unit& u) const {
        const long L = (long)i * G + c; if (L >= nwg) return false;
        int wgid = (int)L; { const int q = nwg / NXCD, r = nwg % NXCD, xcd = wgid % NXCD, off = wgid / NXCD; wgid = (xcd < r ? xcd * (q + 1) : r * (q + 1) + (xcd - r) * q) + off; }
        const int nig = WGM * nN, gid = wgid / nig, fm = gid * WGM, gsz = (nM - fm) < WGM ? (nM - fm) : WGM;
        u.pm = fm + ((wgid % nig) % gsz); u.pn = (wgid % nig) / gsz; return true;
    }
    __device__ __forceinline__ void a_ready(const Unit&) const {}
    __device__ __forceinline__ void done(const Unit&) const {}
};

template <class Epi, class Sched, bool ALIGN_EPI = false, bool SP2 = false>
__device__ __forceinline__ void gemm_phase(PG8_LAS unsigned char* lds, const Gemm g, const Sched& S, const Epi& E, const int tid) {
    const int wid = __builtin_amdgcn_readfirstlane(tid >> 6), lane = tid & 63, wr = wid >> 2, wc = wid & 3, fr = lane & 15, fq = lane >> 4;
    const int K = g.K, nt = K / BK;
    unsigned voffA[2], voffB[2];
#pragma unroll
    for (int i = 0; i < 2; ++i) { int R, C; stage_rc(tid * 16 + i * 8192, R, C); const int Rb = Epi::PERM ? ((R & ~31) + perm32(R & 31)) : R;
        voffA[i] = (unsigned)(R * K + C) * 2u; voffB[i] = (unsigned)(Rb * K + C) * 2u; }
    const size_t kstep = (size_t)(BK * 2);
    const size_t hstep = (size_t)HALF * K * 2;
    const size_t tstep = 2 * hstep;
    const unsigned ldsw = (unsigned)wid * 1024u;
    const int aoff = lds_byte(wr * 64 + fr, fq * 8), boff = lds_byte(wc * 32 + fr, fq * 8);
#define PG8_SA(b, h) (((b) * 2 + (h)) * HTB)
#define PG8_SB(b, h) ((4 + (b) * 2 + (h)) * HTB)
#define PG8_STAGE(bufoff, gbase, voff) do { _Pragma("unroll") for (int _i = 0; _i < 2; ++_i) \
        __builtin_amdgcn_global_load_lds((const unsigned*)((const char*)(gbase) + (voff)[_i]), (PG8_LAS unsigned*)(lds + (bufoff) + ldsw + _i * 8192), 16, 0, 0); } while (0)
#define PG8_LDA(dst, b, h) do { _Pragma("unroll") for (int m = 0; m < 4; ++m) _Pragma("unroll") for (int k = 0; k < 2; ++k) dst[m][k] = *(const PG8_LAS bf16x8*)(lds + PG8_SA(b, h) + aoff + m * 2048 + k * 1024); } while (0)
#define PG8_LDB(dst, b, h) do { _Pragma("unroll") for (int n = 0; n < 2; ++n) _Pragma("unroll") for (int k = 0; k < 2; ++k) dst[n][k] = *(const PG8_LAS bf16x8*)(lds + PG8_SB(b, h) + boff + n * 2048 + k * 1024); } while (0)
#define PG8_MMA(ai, bj, At, Bt) do { __builtin_amdgcn_s_setprio(1); _Pragma("unroll") for (int m = 0; m < 4; ++m) _Pragma("unroll") for (int n = 0; n < 2; ++n) _Pragma("unroll") for (int k = 0; k < 2; ++k) \
        acc[ai][bj][m][n] = __builtin_amdgcn_mfma_f32_16x16x32_bf16(Bt[n][k], At[m][k], acc[ai][bj][m][n], 0, 0, 0); __builtin_amdgcn_s_setprio(0); } while (0)
#define PG8_WAIT_V(n) asm volatile("s_waitcnt vmcnt(" #n ")" ::: "memory")
#define PG8_WAIT_L(n) asm volatile("s_waitcnt lgkmcnt(" #n ")" ::: "memory")
#define PG8_BAR __builtin_amdgcn_s_barrier()
#define PG8_SCHED __builtin_amdgcn_sched_barrier(0)
    Unit cur, nxt; int ui = 0;
    if (!S.next(0, cur)) return;
    f32x4 acc[2][2][4][2];
#pragma unroll
    for (int a = 0; a < 2; ++a)
#pragma unroll
        for (int b = 0; b < 2; ++b)
#pragma unroll
            for (int m = 0; m < 4; ++m)
#pragma unroll
                for (int n = 0; n < 2; ++n) acc[a][b][m][n] = (f32x4){0.f, 0.f, 0.f, 0.f};
    bf16x8 At[4][2], B0[2][2], B1[2][2];
    const char* cA = (const char*)g.A + (size_t)cur.pm * tstep; const char* cB = (const char*)g.Bt + (size_t)cur.pn * tstep;
    S.a_ready(cur);
    if constexpr (SP2) {
        PG8_STAGE(PG8_SB(0, 0), cB, voffB); PG8_STAGE(PG8_SB(0, 1), cB + hstep, voffB); PG8_STAGE(PG8_SA(0, 0), cA, voffA); PG8_STAGE(PG8_SA(0, 1), cA + hstep, voffA);
        if (wr == 1) PG8_BAR;
        PG8_WAIT_V(2); PG8_BAR;
        PG8_STAGE(PG8_SB(1, 0), cB + kstep, voffB); PG8_STAGE(PG8_SA(1, 0), cA + kstep, voffA); PG8_STAGE(PG8_SB(1, 1), cB + hstep + kstep, voffB);
        PG8_WAIT_V(6); PG8_BAR;
    } else {
        PG8_STAGE(PG8_SB(0, 0), cB, voffB); PG8_STAGE(PG8_SA(0, 0), cA, voffA); PG8_STAGE(PG8_SB(0, 1), cB + hstep, voffB); PG8_STAGE(PG8_SA(0, 1), cA + hstep, voffA);
        if (wr == 1) PG8_BAR;
        PG8_WAIT_V(4); PG8_BAR;
        PG8_STAGE(PG8_SB(1, 0), cB + kstep, voffB); PG8_STAGE(PG8_SA(1, 0), cA + kstep, voffA); PG8_STAGE(PG8_SB(1, 1), cB + hstep + kstep, voffB);
        PG8_WAIT_V(6); PG8_BAR;
    }
    for (;;) {
        const bool has_next = S.next(ui + 1, nxt);
        const char* nA = has_next ? (const char*)g.A + (size_t)nxt.pm * tstep : cA; const char* nB = has_next ? (const char*)g.Bt + (size_t)nxt.pn * tstep : cB;
        for (int t = 0; t < nt; t += 2) {
            const bool last = (t == nt - 2);
            const char* a1 = cA + (size_t)(t + 1) * kstep;
            const char* a2 = last ? nA : cA + (size_t)(t + 2) * kstep; const char* b2 = last ? nB : cB + (size_t)(t + 2) * kstep;
            const char* a3 = a2 + kstep; const char* b3 = b2 + kstep;
            if (last && has_next) S.a_ready(nxt);
            if constexpr (SP2) {
            PG8_LDB(B0, 0, 0); PG8_LDB(B1, 0, 1); PG8_SCHED; PG8_LDA(At, 0, 0); PG8_STAGE(PG8_SA(1, 1), a1 + hstep, voffA);
            PG8_WAIT_V(8); PG8_WAIT_L(0); PG8_BAR; PG8_MMA(0, 0, At, B0); PG8_MMA(0, 1, At, B1); PG8_BAR; PG8_SCHED;
            PG8_LDA(At, 0, 1); PG8_STAGE(PG8_SB(0, 0), b2, voffB); PG8_STAGE(PG8_SB(0, 1), b2 + hstep, voffB); PG8_STAGE(PG8_SA(0, 0), a2, voffA);
            PG8_WAIT_V(8); PG8_WAIT_L(0); PG8_BAR; PG8_MMA(1, 0, At, B0); PG8_MMA(1, 1, At, B1); PG8_BAR; PG8_SCHED;
            PG8_LDB(B0, 1, 0); PG8_LDB(B1, 1, 1); PG8_SCHED; PG8_LDA(At, 1, 0); PG8_STAGE(PG8_SA(0, 1), a2 + hstep, voffA);
            PG8_WAIT_V(8); PG8_WAIT_L(0); PG8_BAR; PG8_MMA(0, 0, At, B0); PG8_MMA(0, 1, At, B1); PG8_BAR; PG8_SCHED;
            PG8_LDA(At, 1, 1); PG8_STAGE(PG8_SB(1, 0), b3, voffB); PG8_STAGE(PG8_SB(1, 1), b3 + hstep, voffB); PG8_STAGE(PG8_SA(1, 0), a3, voffA);
            PG8_WAIT_V(8); PG8_WAIT_L(0); PG8_BAR; PG8_MMA(1, 0, At, B0); PG8_MMA(1, 1, At, B1); PG8_BAR; PG8_SCHED;
            } else {
            PG8_LDB(B0, 0, 0); PG8_SCHED; PG8_LDA(At, 0, 0); PG8_STAGE(PG8_SA(1, 1), a1 + hstep, voffA);
            PG8_WAIT_L(8); PG8_BAR; PG8_WAIT_L(0); PG8_MMA(0, 0, At, B0); PG8_BAR; PG8_SCHED;
            PG8_LDB(B1, 0, 1); PG8_STAGE(PG8_SB(0, 0), b2, voffB);
            PG8_BAR; PG8_WAIT_L(0); PG8_MMA(0, 1, At, B1); PG8_BAR;
            PG8_LDA(At, 0, 1); PG8_STAGE(PG8_SA(0, 0), a2, voffA);
            PG8_BAR; PG8_WAIT_L(0); PG8_MMA(1, 0, At, B0); PG8_BAR; PG8_SCHED;
            PG8_STAGE(PG8_SB(0, 1), b2 + hstep, voffB);
            PG8_WAIT_V(6); PG8_BAR; PG8_MMA(1, 1, At, B1); PG8_BAR;
            PG8_LDB(B0, 1, 0); PG8_SCHED; PG8_LDA(At, 1, 0); PG8_STAGE(PG8_SA(0, 1), a2 + hstep, voffA);
            PG8_WAIT_L(8); PG8_BAR; PG8_WAIT_L(0); PG8_MMA(0, 0, At, B0); PG8_BAR; PG8_SCHED;
            PG8_LDB(B1, 1, 1); PG8_STAGE(PG8_SB(1, 0), b3, voffB);
            PG8_BAR; PG8_WAIT_L(0); PG8_MMA(0, 1, At, B1); PG8_BAR;
            PG8_LDA(At, 1, 1); PG8_STAGE(PG8_SA(1, 0), a3, voffA);
            PG8_BAR; PG8_WAIT_L(0); PG8_MMA(1, 0, At, B0); PG8_BAR; PG8_SCHED;
            PG8_STAGE(PG8_SB(1, 1), b3 + hstep, voffB);
            PG8_WAIT_V(6); PG8_BAR; PG8_MMA(1, 1, At, B1); PG8_BAR;
            }
        }
        if constexpr (ALIGN_EPI) { if (wr == 0) PG8_BAR; }
        if constexpr (!Epi::AFTER_DRAIN) { E(acc, cur, wr, wc, fr, fq); S.done(cur); }
        if (!has_next) break;
#pragma unroll
        for (int a = 0; a < 2; ++a)
#pragma unroll
            for (int b = 0; b < 2; ++b)
#pragma unroll
                for (int m = 0; m < 4; ++m)
#pragma unroll
                    for (int n = 0; n < 2; ++n) acc[a][b][m][n] = (f32x4){0.f, 0.f, 0.f, 0.f};
        cur = nxt; cA = nA; cB = nB; ++ui;
        if constexpr (ALIGN_EPI) { if (wr == 1) PG8_BAR; }
    }
    PG8_WAIT_V(0);
    if constexpr (!ALIGN_EPI) { if (wr == 0) PG8_BAR; }
    PG8_BAR;
    if constexpr (Epi::AFTER_DRAIN) { E.fused(acc, cur, wr, wc, fr, fq, lds, wid, lane); S.done(cur); }
#undef PG8_SA
#undef PG8_SB
#undef PG8_STAGE
#undef PG8_LDA
#undef PG8_LDB
#undef PG8_MMA
#undef PG8_WAIT_V
#undef PG8_WAIT_L
#undef PG8_BAR
#undef PG8_SCHED
}
}
template <class F> struct EpiElem { static constexpr bool PERM = false, AFTER_DRAIN = false; F f;
    __device__ __forceinline__ void operator()(const f32x4 (&acc)[2][2][4][2], const pg8::Unit& u, int wr, int wc, int fr, int fq) const {
#pragma unroll
        for (int ai = 0; ai < 2; ++ai)
#pragma unroll
            for (int m = 0; m < 4; ++m)
#pragma unroll
                for (int bj = 0; bj < 2; ++bj)
#pragma unroll
                    for (int n = 0; n < 2; ++n) f(u.pm * 256 + ai * 128 + wr * 64 + m * 16 + fr, u.pn * 256 + bj * 128 + wc * 32 + n * 16 + 4 * fq, acc[ai][bj][m][n]);
    } };

struct ALoadBf16 { const bf16* A; int lda; __device__ __forceinline__ bf16x8 operator()(int row, int k) const { return *(const bf16x8*)(A + (size_t)row * lda + k); } };
template <class AL, class E>
__device__ __forceinline__ void sgemm_tile(int tid, const AL& al, const bf16* Bt, int ldb, int k0, int k1, int row0, int col0, const E& epi) {
    const int lane = tid & 63, wid = tid >> 6, fr = lane & 15, fq = lane >> 4, wm = wid >> 1, wn = wid & 1;
    const int ar = row0 + wm * 32 + fr, bc = col0 + wn * 64 + fr;
    f32x4 acc[2][4];
#pragma unroll
    for (int i = 0; i < 2; ++i)
#pragma unroll
        for (int j = 0; j < 4; ++j) acc[i][j] = (f32x4){0.f, 0.f, 0.f, 0.f};
    const bf16* bp = Bt + (size_t)bc * ldb + 8 * fq;
#pragma unroll 2
    for (int k = k0; k < k1; k += 32) {
        bf16x8 af[2], bf_[4];
#pragma unroll
        for (int i = 0; i < 2; ++i) af[i] = al(ar + 16 * i, k + 8 * fq);
#pragma unroll
        for (int j = 0; j < 4; ++j) bf_[j] = *(const bf16x8*)(bp + (size_t)(16 * j) * ldb + k);
#pragma unroll
        for (int i = 0; i < 2; ++i)
#pragma unroll
            for (int j = 0; j < 4; ++j) acc[i][j] = MFMA16(bf_[j], af[i], acc[i][j]);
    }
#pragma unroll
    for (int i = 0; i < 2; ++i)
#pragma unroll
        for (int j = 0; j < 4; ++j) epi(ar + 16 * i, col0 + wn * 64 + 16 * j + 4 * fq, acc[i][j]);
}

struct FInA {
    bf16 *U, *VP, *QM;
    __device__ __forceinline__ void operator()(int row, int col, f32x4 v) const {
        if (col < 2 * AW) {
            f32x4 gl; gl[0] = gelu_t(v[0]); gl[1] = gelu_t(v[1]); gl[2] = gelu_t(v[2]); gl[3] = gelu_t(v[3]);
            bf16* dst = col < AW ? U + (size_t)row * AW + col : VP + (size_t)row * AW + (col - AW);
            *(u32x2*)dst = pk4(gl);
        } else *(u32x2*)(QM + (size_t)row * MW + (col - 2 * AW)) = pk4(v);
    } };
struct FRes {
    const float* X; float* Z;
    __device__ __forceinline__ void operator()(int row, int col, f32x4 v) const {
        const size_t o = (size_t)row * D + col; const f32x4 x = *(const f32x4*)(X + o); *(f32x4*)(Z + o) = x * ALPHA + v;
    } };
struct FSlab {
    float* ZS;
    __device__ __forceinline__ void operator()(int row, int col, f32x4 v) const { *(f32x4*)(ZS + (size_t)(row - MP) * D + col) = v; } };
struct FUp {
    bf16* H;
    __device__ __forceinline__ void operator()(int row, int col, f32x4 v) const {
        f32x4 r;
#pragma unroll
        for (int i = 0; i < 4; ++i) { const float t = fmaxf(v[i], 0.f); r[i] = t * t; }
        *(u32x2*)(H + (size_t)row * FF + col) = pk4(r);
    } };
__device__ __forceinline__ f32x4 rope4(f32x4 v, f32x4 partner, const float* rope, int posidx, int d) {
    const float* rp = rope + (size_t)posidx * 16 + (d & 7);
    const f32x4 cs = *(const f32x4*)rp, sn = *(const f32x4*)(rp + 8);
    return (d & 8) ? v * cs + partner * sn : v * cs - partner * sn;
}
__device__ __forceinline__ f32x4 shfl_xor4(f32x4 v, int m) { f32x4 r; r[0] = __shfl_xor(v[0], m); r[1] = __shfl_xor(v[1], m); r[2] = __shfl_xor(v[2], m); r[3] = __shfl_xor(v[3], m); return r; }
struct FKV {
    const float* rope; float* out;
    bf16 *KS, *VTS, *KW, *VTW;
    size_t o_cmp_p, o_slc_p, o_win_p, o_cmp_s, o_slc_s, o_win_s;
    __device__ __forceinline__ void operator()(int row, int col, f32x4 v) const {
        const int br = col >> 9, cc = col & 511, c = (cc >> 8) & 1, hh = (cc >> 6) & 3, d = cc & 63;
        const bool prompt = row < MP;
        int b, t, posidx;
        if (prompt) { b = row >> 12; t = row & 4095; posidx = t; } else { const int r = row - MP; b = r >> 2; t = r & 3; posidx = SP + t; }
        const f32x4 partner = shfl_xor4(v, 32);
        if (c == 0 && d < 16) v = rope4(v, partner, rope, posidx, d);
        if (prompt) {
            if (br == 0) *(f32x4*)(out + o_cmp_p + (size_t)row * 512 + cc) = v;
            else if (br == 1) *(f32x4*)(out + o_slc_p + (size_t)row * 512 + cc) = v;
            else if (t >= SP - 512) *(f32x4*)(out + o_win_p + ((size_t)b * 512 + (t - (SP - 512))) * 512 + cc) = v;
            if (br >= 1) {
                if (c == 0) { bf16* K = br == 1 ? KS : KW; *(u32x2*)(K + ((size_t)(b * 4 + hh) * SP + t) * 64 + d) = pk4(v); }
                else { bf16* VT = br == 1 ? VTS : VTW; bf16* p = VT + ((size_t)(b * 4 + hh) * 64 + d) * SP + t; const u32x2 w = pk4(v);
                       p[0] = (bf16)(w.x & 0xffffu); p[SP] = (bf16)(w.x >> 16); p[2 * SP] = (bf16)(w.y & 0xffffu); p[3 * SP] = (bf16)(w.y >> 16); }
            }
        } else {
            if (br == 0) *(f32x4*)(out + o_cmp_s + (size_t)(b * 4 + t) * 512 + cc) = v;
            else if (br == 1) *(f32x4*)(out + o_slc_s + (size_t)(b * 4 + t) * 512 + cc) = v;
            else *(f32x4*)(out + o_win_s + ((size_t)b * 512 + 508 + t) * 512 + cc) = v;
        }
    } };
struct FInB {
    const float* rope; bf16 *Q, *QM; float* G;
    __device__ __forceinline__ void operator()(int row, int col, f32x4 v) const {
        const int posidx = row < MP ? (row & 4095) : SP + ((row - MP) & 3);
        const f32x4 partner = shfl_xor4(v, 32);
        if (col < AW) { const int d = col & 63; if (d < 16) v = rope4(v, partner, rope, posidx, d); *(u32x2*)(Q + (size_t)row * AW + col) = pk4(v); }
        else if (col < AW + MW) *(u32x2*)(QM + (size_t)row * MW + (col - AW)) = pk4(v);
        else if (col < AW + MW + 36) { f32x4 s; s[0] = sigmoid_f(v[0]); s[1] = sigmoid_f(v[1]); s[2] = sigmoid_f(v[2]); s[3] = sigmoid_f(v[3]); *(f32x4*)(G + (size_t)row * 36 + (col - AW - MW)) = s; }
    } };
struct FMemKV {
    float* out; bf16 *KM, *VTM;
    __device__ __forceinline__ void operator()(int row, int col, f32x4 v) const {
        const int l = col >> 9, cc = col & 511, c = cc >> 8, hh = (cc >> 6) & 3, d = cc & 63, b = row >> 8, m = row & 255;
        *(f32x4*)(out + ((size_t)l * 1024 + row) * 512 + cc) = v;
        if (c == 0) *(u32x2*)(KM + ((size_t)((l * 4 + b) * 4 + hh) * 256 + m) * 64 + d) = pk4(v);
        else { bf16* p = VTM + ((size_t)((l * 4 + b) * 4 + hh) * 64 + d) * 256 + m; const u32x2 w = pk4(v);
               p[0] = (bf16)(w.x & 0xffffu); p[256] = (bf16)(w.x >> 16); p[512] = (bf16)(w.y & 0xffffu); p[768] = (bf16)(w.y >> 16); }
    } };
constexpr int LDS_BYTES = 147456, MISC_OFF = 131072 + 320, INPTR_OFF = 131072 + 1024;
constexpr size_t al256(size_t x) { return (x + 255) & ~(size_t)255; }
constexpr size_t WS_CTL = 0, CTL_BYTES = 1u << 20;
constexpr size_t WS_W_INA = CTL_BYTES, WS_W_OUTA = WS_W_INA + (size_t)2 * NIA * D * 2, WS_W_INB = WS_W_OUTA + (size_t)2 * D * D * 2, WS_W_OUTB = WS_W_INB + (size_t)2 * NIBP * D * 2,
                 WS_W_KV = WS_W_OUTB + (size_t)2 * D * D * 2, WS_W_UP = WS_W_KV + (size_t)NKV * D * 2, WS_W_DOWN = WS_W_UP + (size_t)4 * FF * D * 2, WS_W_MEM = WS_W_DOWN + (size_t)4 * FF * D * 2,
                 WS_W_PHI1T = WS_W_MEM + (size_t)2048 * D * 2, WS_W_PHI2T = WS_W_PHI1T + (size_t)2 * 128 * 2048 * 2, WS_PEB = WS_W_PHI2T + (size_t)2 * 64 * 128 * 2, WS_ROPE = WS_PEB + 1024,
                 WS_XRES = al256(WS_ROPE + (size_t)(SP + TS) * 16 * 4), WS_Z = WS_XRES + (size_t)MT * D * 4, WS_ZS = WS_Z + (size_t)MT * D * 4, WS_GT = WS_ZS + (size_t)8 * MS * D * 4,
                 WS_KVCS = al256(WS_GT + (size_t)MT * 36 * 4), WS_XB = WS_KVCS + (size_t)BS * 4 * 512 * 128 * 4, WS_U = WS_XB + (size_t)MT * D * 2, WS_VP = WS_U + (size_t)MT * AW * 2,
                 WS_QM = WS_VP + (size_t)MT * AW * 2, WS_QB = WS_QM + (size_t)MT * MW * 2, WS_CAT = WS_QB + (size_t)MT * AW * 2, WS_HB = WS_CAT + (size_t)MT * D * 2,
                 WS_KSLC = WS_HB + (size_t)MT * FF * 2, WS_VTSLC = WS_KSLC + (size_t)16 * SP * 64 * 2, WS_KWIN = WS_VTSLC + (size_t)16 * SP * 64 * 2, WS_VTWIN = WS_KWIN + (size_t)16 * SP * 64 * 2,
                 WS_KCMP = WS_VTWIN + (size_t)16 * SP * 64 * 2, WS_VTCMP = WS_KCMP + (size_t)16 * 256 * 64 * 2, WS_KMEM = WS_VTCMP + (size_t)16 * 256 * 64 * 2, WS_VTMEM = WS_KMEM + (size_t)64 * 256 * 64 * 2,
                 WS_END = WS_VTMEM + (size_t)64 * 256 * 64 * 2;
struct Frame {
    LAS unsigned char* lds;
    int tid, lane, wid, G, bid;
    unsigned char* ws; float* out;
    __device__ __forceinline__ const void* inp(int i) const { const LAS unsigned* p = (const LAS unsigned*)(lds + INPTR_OFF) + 2 * i;
        const unsigned lo = __builtin_amdgcn_readfirstlane(p[0]), hi = __builtin_amdgcn_readfirstlane(p[1]); return (const void*)(((unsigned long long)hi << 32) | lo); }
    __device__ __forceinline__ const float* x_prompt() const { return (const float*)inp(0); }
    __device__ __forceinline__ const float* x_sample() const { return (const float*)inp(1); }
    __device__ __forceinline__ const float* cache_cmp() const { return (const float*)inp(2); }
    __device__ __forceinline__ const float* cache_slc() const { return (const float*)inp(3); }
    __device__ __forceinline__ const float* cache_win() const { return (const float*)inp(4); }
    __device__ __forceinline__ const float* cache_mem() const { return (const float*)inp(5); }
    __device__ __forceinline__ const int* page_table() const { return (const int*)inp(6); }
    __device__ __forceinline__ const float* mem_prompt() const { return (const float*)inp(7); }
    __device__ __forceinline__ const float* w_in_a() const { return (const float*)inp(8); }
    __device__ __forceinline__ const float* ln_v_g() const { return (const float*)inp(9); }
    __device__ __forceinline__ const float* ln_v_b() const { return (const float*)inp(10); }
    __device__ __forceinline__ const float* w_spatial() const { return (const float*)inp(11); }
    __device__ __forceinline__ const float* b_spatial() const { return (const float*)inp(12); }
    __device__ __forceinline__ const float* w_out_a() const { return (const float*)inp(13); }
    __device__ __forceinline__ const float* w_in_b() const { return (const float*)inp(14); }
    __device__ __forceinline__ const float* w_out_b() const { return (const float*)inp(15); }
    __device__ __forceinline__ const float* w_kv() const { return (const float*)inp(16); }
    __device__ __forceinline__ const float* cmp_pe() const { return (const float*)inp(17); }
    __device__ __forceinline__ const float* w_phi1() const { return (const float*)inp(18); }
    __device__ __forceinline__ const float* w_phi2() const { return (const float*)inp(19); }
    __device__ __forceinline__ const float* w_mem_kv() const { return (const float*)inp(20); }
    __device__ __forceinline__ const float* ln1_g() const { return (const float*)inp(21); }
    __device__ __forceinline__ const float* ln1_b() const { return (const float*)inp(22); }
    __device__ __forceinline__ const float* ln2_g() const { return (const float*)inp(23); }
    __device__ __forceinline__ const float* ln2_b() const { return (const float*)inp(24); }
    __device__ __forceinline__ const float* w_up() const { return (const float*)inp(25); }
    __device__ __forceinline__ const float* w_down() const { return (const float*)inp(26); }
    __device__ __forceinline__ bf16* W_INA() const { return (bf16*)(ws + WS_W_INA); }
    __device__ __forceinline__ bf16* W_OUTA() const { return (bf16*)(ws + WS_W_OUTA); }
    __device__ __forceinline__ bf16* W_INB() const { return (bf16*)(ws + WS_W_INB); }
    __device__ __forceinline__ bf16* W_OUTB() const { return (bf16*)(ws + WS_W_OUTB); }
    __device__ __forceinline__ bf16* W_KV() const { return (bf16*)(ws + WS_W_KV); }
    __device__ __forceinline__ bf16* W_UP() const { return (bf16*)(ws + WS_W_UP); }
    __device__ __forceinline__ bf16* W_DOWN() const { return (bf16*)(ws + WS_W_DOWN); }
    __device__ __forceinline__ bf16* W_MEM() const { return (bf16*)(ws + WS_W_MEM); }
    __device__ __forceinline__ bf16* W_PHI1T() const { return (bf16*)(ws + WS_W_PHI1T); }
    __device__ __forceinline__ bf16* W_PHI2T() const { return (bf16*)(ws + WS_W_PHI2T); }
    __device__ __forceinline__ float* PEB() const { return (float*)(ws + WS_PEB); }
    __device__ __forceinline__ float* ROPE() const { return (float*)(ws + WS_ROPE); }
    __device__ __forceinline__ float* XRES() const { return (float*)(ws + WS_XRES); }
    __device__ __forceinline__ float* Z() const { return (float*)(ws + WS_Z); }
    __device__ __forceinline__ float* ZS() const { return (float*)(ws + WS_ZS); }
    __device__ __forceinline__ float* GT() const { return (float*)(ws + WS_GT); }
    __device__ __forceinline__ float* KVCS() const { return (float*)(ws + WS_KVCS); }
    __device__ __forceinline__ bf16* XB() const { return (bf16*)(ws + WS_XB); }
    __device__ __forceinline__ bf16* U() const { return (bf16*)(ws + WS_U); }
    __device__ __forceinline__ bf16* VP() const { return (bf16*)(ws + WS_VP); }
    __device__ __forceinline__ bf16* QM() const { return (bf16*)(ws + WS_QM); }
    __device__ __forceinline__ bf16* QB() const { return (bf16*)(ws + WS_QB); }
    __device__ __forceinline__ bf16* CAT() const { return (bf16*)(ws + WS_CAT); }
    __device__ __forceinline__ bf16* HB() const { return (bf16*)(ws + WS_HB); }
    __device__ __forceinline__ bf16* KSLC() const { return (bf16*)(ws + WS_KSLC); }
    __device__ __forceinline__ bf16* VTSLC() const { return (bf16*)(ws + WS_VTSLC); }
    __device__ __forceinline__ bf16* KWIN() const { return (bf16*)(ws + WS_KWIN); }
    __device__ __forceinline__ bf16* VTWIN() const { return (bf16*)(ws + WS_VTWIN); }
    __device__ __forceinline__ bf16* KCMP() const { return (bf16*)(ws + WS_KCMP); }
    __device__ __forceinline__ bf16* VTCMP() const { return (bf16*)(ws + WS_VTCMP); }
    __device__ __forceinline__ bf16* KMEM() const { return (bf16*)(ws + WS_KMEM); }
    __device__ __forceinline__ bf16* VTMEM() const { return (bf16*)(ws + WS_VTMEM); }
};
constexpr size_t O_Y_P = 0, O_Y_S = O_Y_P + (size_t)MP * D, O_CMP_P = O_Y_S + (size_t)MS * D, O_SLC_P = O_CMP_P + (size_t)MP * 512, O_WIN_P = O_SLC_P + (size_t)MP * 512,
                 O_MEM_P = O_WIN_P + (size_t)BP * 512 * 512, O_CMP_S = O_MEM_P + (size_t)4 * BP * 256 * 512, O_SLC_S = O_CMP_S + (size_t)MS * 512, O_WIN_S = O_SLC_S + (size_t)MS * 512,
                 O_GV_S = O_WIN_S + (size_t)BS * 512 * 512, O_END = O_GV_S + (size_t)2 * MS * AW;

template <class RM>
__device__ __forceinline__ void tr_item(const float* W, int K, int N, bf16* WT, const RM& rm, LAS float* scr, int item, int lane) {
    const int nblk = (N + 31) / 32, kb = item / nblk, nb = item % nblk, k0 = 64 * kb, n0 = 32 * nb;
    const int nl = lane & 31, nn = n0 + nl;
#pragma unroll 8
    for (int i = 0; i < 32; ++i) { const int kk = 2 * i + (lane >> 5); scr[kk * 33 + nl] = nn < N ? W[(size_t)(k0 + kk) * N + nn] : 0.f; }
    LDS_WAIT(); asm volatile("" ::: "memory");
    const int c = lane & 7;
#pragma unroll
    for (int j = 0; j < 4; ++j) { const int n = (lane >> 3) + 8 * j; const LAS float* s = scr + (8 * c) * 33 + n;
        u32x4 o; o.x = pk2(s[0 * 33], s[1 * 33]); o.y = pk2(s[2 * 33], s[3 * 33]); o.z = pk2(s[4 * 33], s[5 * 33]); o.w = pk2(s[6 * 33], s[7 * 33]);
        if (n0 + n < N) *(u32x4*)(WT + (size_t)rm(n0 + n) * K + k0 + 8 * c) = o; }
    LDS_WAIT(); asm volatile("" ::: "memory");
}
struct RMId { int off; __device__ __forceinline__ int operator()(int n) const { return off + n; } };
struct RMInB { __device__ __forceinline__ int operator()(int n) const { return n < AW ? n : (n < AW + 36 ? AW + MW + (n - AW) : AW + (n - AW - 36)); } };

__device__ __forceinline__ void p_prologue(Frame& F) {
    LAS float* scr = (LAS float*)(F.lds + F.wid * 16384);
    const int gw = F.bid * 8 + F.wid, NGW = F.G * 8, gt = F.bid * 512 + F.tid, NGT = F.G * 512;
    {
        constexpr int I_INA = (D / 64) * (NIA / 32), I_SQ = (D / 64) * (D / 32), I_INB = (D / 64) * ((NIB + 31) / 32), I_KV = (D / 64) * (NKV / 32), I_UP = (D / 64) * (FF / 32), I_DN = (FF / 64) * (D / 32), I_MEM = (D / 64) * (512 / 32);
        constexpr int NITEMS = 2 * I_INA + 2 * I_SQ + 2 * I_INB + 2 * I_SQ + I_KV + 4 * I_UP + 4 * I_DN + 4 * I_MEM;
        for (int it = gw; it < NITEMS; it += NGW) {
            int r = it;
            if (r < 2 * I_INA) { const int l = r / I_INA; tr_item(F.w_in_a() + (size_t)l * D * NIA, D, NIA, F.W_INA() + (size_t)l * NIA * D, RMId{0}, scr, r % I_INA, F.lane); continue; } r -= 2 * I_INA;
            if (r < 2 * I_SQ) { const int l = r / I_SQ; tr_item(F.w_out_a() + (size_t)l * D * D, D, D, F.W_OUTA() + (size_t)l * D * D, RMId{0}, scr, r % I_SQ, F.lane); continue; } r -= 2 * I_SQ;
            if (r < 2 * I_INB) { const int l = r / I_INB; tr_item(F.w_in_b() + (size_t)l * D * NIB, D, NIB, F.W_INB() + (size_t)l * NIBP * D, RMInB{}, scr, r % I_INB, F.lane); continue; } r -= 2 * I_INB;
            if (r < 2 * I_SQ) { const int l = r / I_SQ; tr_item(F.w_out_b() + (size_t)l * D * D, D, D, F.W_OUTB() + (size_t)l * D * D, RMId{0}, scr, r % I_SQ, F.lane); continue; } r -= 2 * I_SQ;
            if (r < I_KV) { tr_item(F.w_kv(), D, NKV, F.W_KV(), RMId{0}, scr, r, F.lane); continue; } r -= I_KV;
            if (r < 4 * I_UP) { const int l = r / I_UP; tr_item(F.w_up() + (size_t)l * D * FF, D, FF, F.W_UP() + (size_t)l * FF * D, RMId{0}, scr, r % I_UP, F.lane); continue; } r -= 4 * I_UP;
            if (r < 4 * I_DN) { const int l = r / I_DN; tr_item(F.w_down() + (size_t)l * FF * D, FF, D, F.W_DOWN() + (size_t)l * D * FF, RMId{0}, scr, r % I_DN, F.lane); continue; } r -= 4 * I_DN;
            { const int l = r / I_MEM; tr_item(F.w_mem_kv() + (size_t)l * D * 512, D, 512, F.W_MEM(), RMId{l * 512}, scr, r % I_MEM, F.lane); }
        }
    }
    for (int i = gt; i < 2 * (NIBP - NIB) * D / 8; i += NGT) { const int l = i / ((NIBP - NIB) * D / 8), r = i % ((NIBP - NIB) * D / 8);
        *(u32x4*)(F.W_INB() + (size_t)l * NIBP * D + (size_t)NIB * D + (size_t)r * 8) = (u32x4){0u, 0u, 0u, 0u}; }
    for (int row = gw; row < MT; row += NGW) {
        const float* src = row < MP ? F.x_prompt() + (size_t)row * D : F.x_sample() + (size_t)(row - MP) * D;
#pragma unroll
        for (int j = 0; j < 4; ++j) { const f32x4 v = *(const f32x4*)(src + 256 * j + 4 * F.lane);
            *(f32x4*)(F.XRES() + (size_t)row * D + 256 * j + 4 * F.lane) = v; *(u32x2*)(F.XB() + (size_t)row * D + 256 * j + 4 * F.lane) = pk4(v); }
    }
    for (int rr = gw; rr < BS * 508; rr += NGW) { const int b = rr / 508, r = rr % 508;
        const float* src = F.cache_win() + ((size_t)b * 512 + r + 4) * 512; float* dst = F.out + O_WIN_S + ((size_t)b * 512 + r) * 512;
#pragma unroll
        for (int j = 0; j < 2; ++j) *(f32x4*)(dst + 256 * j + 4 * F.lane) = *(const f32x4*)(src + 256 * j + 4 * F.lane); }
    for (int i = gt; i < (SP + TS) * 8; i += NGT) { const int pi = i >> 3, k = i & 7; const double pos = pi < SP ? (double)pi : (double)(PAST + pi - SP);
        double inv = 1.0; for (int j = 0; j < k; ++j) inv *= 0.19392274474868576;
        double rev = pos * inv * 0.15915494309189535; rev -= __builtin_floor(rev);
        F.ROPE()[(size_t)pi * 16 + k] = __builtin_amdgcn_cosf((float)rev); F.ROPE()[(size_t)pi * 16 + 8 + k] = __builtin_amdgcn_sinf((float)rev); }
    for (int i = gt; i < 2 * 128 * 2048; i += NGT) { const int c = i / (128 * 2048), e = (i / 2048) % 128, k = i % 2048, s = k >> 6, d = k & 63;
        const float v = F.w_phi1()[((size_t)(s * 2 + c) * 64 + d) * 128 + e]; F.W_PHI1T()[i] = (bf16)(pk2(v, 0.f) & 0xffffu); }
    for (int i = gt; i < 2 * 64 * 128; i += NGT) { const int c = i / (64 * 128), d = (i / 128) % 64, e = i % 128;
        const float v = F.w_phi2()[((size_t)c * 128 + e) * 64 + d]; F.W_PHI2T()[i] = (bf16)(pk2(v, 0.f) & 0xffffu); }
    for (int o = gw; o < 256; o += NGW) { const int c = o >> 7, e = o & 127; float a = 0.f;
        for (int k = F.lane; k < 2048; k += 64) { const int s = k >> 6, d = k & 63; a += F.cmp_pe()[(s * 2 + c) * 64 + d] * F.w_phi1()[((size_t)(s * 2 + c) * 64 + d) * 128 + e]; }
        a = wave_sum(a); if (F.lane == 0) F.PEB()[o] = a; }
    for (int i = gt; i < 16 * 64; i += NGT) { const int bg = i >> 6, d = i & 63; F.KCMP()[((size_t)bg * 256 + 255) * 64 + d] = 0; F.VTCMP()[((size_t)bg * 64 + d) * 256 + 255] = 0; }
}

__device__ __forceinline__ void ln_pass(Frame& F, const float* g, const float* bta, int nslab, float* outf_p, float* outf_s, bf16* outb) {
    const int gw = F.bid * 8 + F.wid, NGW = F.G * 8;
    for (int row = gw; row < MT; row += NGW) {
        f32x4 v[4]; float s = 0.f;
        if (row < MP) {
#pragma unroll
            for (int j = 0; j < 4; ++j) v[j] = *(const f32x4*)(F.Z() + (size_t)row * D + 256 * j + 4 * F.lane);
        } else {
#pragma unroll
            for (int j = 0; j < 4; ++j) { v[j] = *(const f32x4*)(F.XRES() + (size_t)row * D + 256 * j + 4 * F.lane) * ALPHA;
                for (int ks = 0; ks < nslab; ++ks) v[j] += *(const f32x4*)(F.ZS() + ((size_t)ks * MS + (row - MP)) * D + 256 * j + 4 * F.lane); }
        }
#pragma unroll
        for (int j = 0; j < 4; ++j) s += (v[j][0] + v[j][1]) + (v[j][2] + v[j][3]);
        const float mean = wave_sum(s) * (1.f / D); float s2 = 0.f;
#pragma unroll
        for (int j = 0; j < 4; ++j) { v[j] = v[j] - mean; s2 += (v[j][0] * v[j][0] + v[j][1] * v[j][1]) + (v[j][2] * v[j][2] + v[j][3] * v[j][3]); }
        const float rstd = 1.f / sqrtf(wave_sum(s2) * (1.f / D) + LN_EPS);
        float* of = row < MP ? outf_p + (size_t)row * D : outf_s + (size_t)(row - MP) * D;
#pragma unroll
        for (int j = 0; j < 4; ++j) { const int c = 256 * j + 4 * F.lane; const f32x4 o = v[j] * rstd * *(const f32x4*)(g + c) + *(const f32x4*)(bta + c);
            *(f32x4*)(of + c) = o; if (outb) *(u32x2*)(outb + (size_t)row * D + c) = pk4(o); }
    }
}
template <int NH> struct Flash {
    f32x4 o[NH][4]; float m[NH], l[NH];
    __device__ __forceinline__ void init() {
#pragma unroll
        for (int r = 0; r < NH; ++r) { m[r] = -1e30f; l[r] = 0.f;
#pragma unroll
            for (int n = 0; n < 4; ++n) o[r][n] = (f32x4){0.f, 0.f, 0.f, 0.f}; } }
    __device__ __forceinline__ void finish() {
#pragma unroll
        for (int r = 0; r < NH; ++r) { float lt = l[r]; lt += __shfl_xor(lt, 16); lt += __shfl_xor(lt, 32); const float inv = lt > 0.f ? 1.0f / lt : 0.f;
#pragma unroll
            for (int n = 0; n < 4; ++n) o[r][n] = o[r][n] * inv; } }
};
struct KVFrag { bf16x8 ka0, ka1, kb0, kb1, vf[4]; };
__device__ __forceinline__ void load_kv(KVFrag& f, const bf16* K, const bf16* Vt, int ldv, int key0, int qi, int g4) {
    const bf16* kp = K + (size_t)(key0 + qi) * 64 + 8 * g4;
    f.ka0 = *(const bf16x8*)(kp); f.ka1 = *(const bf16x8*)(kp + 32); f.kb0 = *(const bf16x8*)(kp + 16 * 64); f.kb1 = *(const bf16x8*)(kp + 16 * 64 + 32);
#pragma unroll
    for (int n = 0; n < 4; ++n) { const bf16* vp = Vt + (size_t)(16 * n + qi) * ldv + key0 + 4 * g4; const u32x2 lo = *(const u32x2*)vp, hi = *(const u32x2*)(vp + 16);
        f.vf[n] = __builtin_bit_cast(bf16x8, (u32x4){lo.x, lo.y, hi.x, hi.y}); }
}
template <int NH, class Mask>
__device__ __forceinline__ void flash_step(Flash<NH>& st, const bf16x8 (&qf)[NH][2], const bf16* K, const bf16* Vt, int ldv, int key0, int qi, int g4, const Mask& mask) {
    KVFrag f; load_kv(f, K, Vt, ldv, key0, qi, g4);
    bool va[4], vb[4];
#pragma unroll
    for (int j = 0; j < 4; ++j) { va[j] = mask(key0 + 4 * g4 + j); vb[j] = mask(key0 + 16 + 4 * g4 + j); }
#pragma unroll
    for (int r = 0; r < NH; ++r) {
        f32x4 sa = MFMA16(f.ka0, qf[r][0], ((f32x4){0.f, 0.f, 0.f, 0.f})); sa = MFMA16(f.ka1, qf[r][1], sa);
        f32x4 sb = MFMA16(f.kb0, qf[r][0], ((f32x4){0.f, 0.f, 0.f, 0.f})); sb = MFMA16(f.kb1, qf[r][1], sb);
        float mx = NEG_INF;
#pragma unroll
        for (int j = 0; j < 4; ++j) { sa[j] = va[j] ? sa[j] * QSC : NEG_INF; sb[j] = vb[j] ? sb[j] * QSC : NEG_INF; mx = fmaxf(mx, fmaxf(sa[j], sb[j])); }
        mx = fmaxf(mx, __shfl_xor(mx, 16)); mx = fmaxf(mx, __shfl_xor(mx, 32));
        const float mn = fmaxf(st.m[r], mx), alpha = ex2(st.m[r] - mn); st.m[r] = mn;
        float ps = 0.f;
#pragma unroll
        for (int j = 0; j < 4; ++j) { sa[j] = ex2(sa[j] - mn); sb[j] = ex2(sb[j] - mn); ps += sa[j] + sb[j]; }
        st.l[r] = st.l[r] * alpha + ps;
        const bf16x8 pf = pk8(sa, sb);
#pragma unroll
        for (int n = 0; n < 4; ++n) { st.o[r][n] = st.o[r][n] * alpha; st.o[r][n] = MFMA16(f.vf[n], pf, st.o[r][n]); }
    }
    asm volatile("" ::: "memory");
}
template <int NH> __device__ __forceinline__ void load_q(bf16x8 (&qf)[NH][2], const bf16* Q, int ldq, int row, int g4) {
#pragma unroll
    for (int r = 0; r < NH; ++r) { const bf16* p = Q + (size_t)row * ldq + r * 64 + 8 * g4; qf[r][0] = *(const bf16x8*)p; qf[r][1] = *(const bf16x8*)(p + 32); }
}

__device__ __forceinline__ void mem_prompt_unit(Frame& F, int l, int unit) {
    const int qt = unit & 31, hh = (unit >> 5) & 3, b = unit >> 7, qi = F.lane & 15, g4 = F.lane >> 4;
    const int row = b * SP + qt * 128 + F.wid * 16 + qi;
    const bf16* K = F.KMEM() + (size_t)((l * 4 + b) * 4 + hh) * 256 * 64; const bf16* Vt = F.VTMEM() + (size_t)((l * 4 + b) * 4 + hh) * 64 * 256;
    bf16x8 qf[1][2]; load_q<1>(qf, F.QM() + hh * 64, MW, row, g4);
    Flash<1> st; st.init();
    for (int key0 = 0; key0 < 256; key0 += 32) flash_step<1>(st, qf, K, Vt, 256, key0, qi, g4, [](int) { return true; });
    st.finish();
#pragma unroll
    for (int n = 0; n < 4; ++n) *(u32x2*)(F.CAT() + (size_t)row * D + AW + hh * 64 + 16 * n + 4 * g4) = pk4(st.o[0][n]);
}

__device__ __forceinline__ void spatial_unit(Frame& F, int l, int unit) {
    const int g = unit & 3, chunk = unit >> 2;
    const bool samp = chunk >= 128; const int row0 = samp ? MP + 4 * (chunk - 128) : chunk * 128, nrows = samp ? 4 : 128;
    LAS float* stat = (LAS float*)F.lds;
    LAS bf16* vT = (LAS bf16*)(F.lds + 1024);
    for (int r = F.wid * 16; r < F.wid * 16 + 16; ++r) {
        if (r < nrows) {
            const bf16* vp = F.VP() + (size_t)(row0 + r) * AW + 12 * F.lane; float x[12];
#pragma unroll
            for (int j = 0; j < 3; ++j) { const u32x2 w = *(const u32x2*)(vp + 4 * j); x[4 * j] = bf2f((bf16)(w.x & 0xffffu)); x[4 * j + 1] = bf2f((bf16)(w.x >> 16)); x[4 * j + 2] = bf2f((bf16)(w.y & 0xffffu)); x[4 * j + 3] = bf2f((bf16)(w.y >> 16)); }
            float s = 0.f;
#pragma unroll
            for (int j = 0; j < 12; ++j) s += x[j];
            const float mean = wave_sum(s) * (1.f / AW); float s2 = 0.f;
#pragma unroll
            for (int j = 0; j < 12; ++j) { const float dd = x[j] - mean; s2 += dd * dd; }
            const float rstd = 1.f / sqrtf(wave_sum(s2) * (1.f / AW) + LN_EPS);
            if (F.lane == 0) { stat[2 * r] = mean; stat[2 * r + 1] = rstd; }
        }
    }
    __syncthreads();
    const float* gam = F.ln_v_g() + l * AW + g * 192; const float* bet = F.ln_v_b() + l * AW + g * 192;
    for (int idx = F.tid; idx < 128 * 48; idx += 512) {
        const int r = idx / 48, cg = idx % 48;
        f32x4 v = {0.f, 0.f, 0.f, 0.f};
        if (r < nrows) {
            const u32x2 w = *(const u32x2*)(F.VP() + (size_t)(row0 + r) * AW + g * 192 + 4 * cg);
            const float mean = stat[2 * r], rstd = stat[2 * r + 1];
            const f32x4 x = {bf2f((bf16)(w.x & 0xffffu)), bf2f((bf16)(w.x >> 16)), bf2f((bf16)(w.y & 0xffffu)), bf2f((bf16)(w.y >> 16))};
            v = (x - mean) * rstd * *(const f32x4*)(gam + 4 * cg) + *(const f32x4*)(bet + 4 * cg);
            if (samp) *(f32x4*)(F.out + O_GV_S + ((size_t)l * MS + (row0 - MP) + r) * AW + g * 192 + 4 * cg) = v;
        }
        const u32x2 pv = pk4(v);
        vT[(4 * cg + 0) * 136 + r] = (bf16)(pv.x & 0xffffu); vT[(4 * cg + 1) * 136 + r] = (bf16)(pv.x >> 16); vT[(4 * cg + 2) * 136 + r] = (bf16)(pv.y & 0xffffu); vT[(4 * cg + 3) * 136 + r] = (bf16)(pv.y >> 16);
    }
    __syncthreads();
    if (F.wid * 16 < nrows) {
        const int fr = F.lane & 15, fq = F.lane >> 4, t = F.wid * 16 + fr;
        const float* Wg = F.w_spatial() + ((size_t)(l * 4 + g) * 128 + t) * 128;
        f32x4 acc[12];
#pragma unroll
        for (int n = 0; n < 12; ++n) acc[n] = (f32x4){0.f, 0.f, 0.f, 0.f};
        for (int ks = 0; ks <= (F.wid >> 1); ++ks) {
            const int s0 = 32 * ks + 8 * fq;
            f32x4 w0 = *(const f32x4*)(Wg + s0), w1 = *(const f32x4*)(Wg + s0 + 4);
#pragma unroll
            for (int j = 0; j < 4; ++j) { if (s0 + j > t) w0[j] = 0.f; if (s0 + 4 + j > t) w1[j] = 0.f; }
            const bf16x8 wf = pk8(w0, w1);
#pragma unroll
            for (int n = 0; n < 12; ++n) { const bf16x8 vfrag = *(const LAS bf16x8*)(vT + (16 * n + fr) * 136 + s0); acc[n] = MFMA16(vfrag, wf, acc[n]); }
        }
        if (t < nrows) {
            const float bs = F.b_spatial()[(l * 4 + g) * 128 + t];
#pragma unroll
            for (int n = 0; n < 12; ++n) { const int c = g * 192 + 16 * n + 4 * fq; const u32x2 uw = *(const u32x2*)(F.U() + (size_t)(row0 + t) * AW + c);
                f32x4 o; o[0] = (acc[n][0] + bs) * bf2f((bf16)(uw.x & 0xffffu)); o[1] = (acc[n][1] + bs) * bf2f((bf16)(uw.x >> 16)); o[2] = (acc[n][2] + bs) * bf2f((bf16)(uw.y & 0xffffu)); o[3] = (acc[n][3] + bs) * bf2f((bf16)(uw.y >> 16));
                *(u32x2*)(F.CAT() + (size_t)(row0 + t) * D + c) = pk4(o); }
        }
    }
    __syncthreads();
}
__device__ __forceinline__ void nsa_prompt_unit(Frame& F, int unit) {
    const int bg = unit & 15, qt = unit < 256 ? 31 - (unit >> 4) : ((unit - 256) >> 4);
    const int b = bg >> 2, g = bg & 3, qi = F.lane & 15, g4 = F.lane >> 4;
    const int t0 = qt * 128 + F.wid * 16, t = t0 + qi, row = b * SP + t;
    bf16x8 qf[3][2]; load_q<3>(qf, F.QB() + g * 192, AW, row, g4);
#define NSA_LATE(x) asm volatile("" : "+v"(x))
    LAS float* park = (LAS float*)F.lds + F.tid;
    unsigned mlo = 0u, mhi = 0u;
    {
        const bf16* Kc = F.KCMP() + (size_t)bg * 256 * 64; const bf16* Vc = F.VTCMP() + (size_t)bg * 64 * 256;
        const int nvq = t >= 31 ? ((t - 31) >> 4) + 1 : 0;
        const int nvmax = t0 + 15 >= 31 ? ((t0 + 15 - 31) >> 4) + 1 : 0;
        float m[3], l[3];
#pragma unroll
        for (int r = 0; r < 3; ++r) { m[r] = -1e30f; l[r] = 0.f; }
        for (int key0 = 0; key0 < nvmax; key0 += 32) {
            const bf16* kp = Kc + (size_t)(key0 + qi) * 64 + 8 * g4;
            const bf16x8 ka0 = *(const bf16x8*)(kp), ka1 = *(const bf16x8*)(kp + 32), kb0 = *(const bf16x8*)(kp + 1024), kb1 = *(const bf16x8*)(kp + 1024 + 32);
#pragma unroll
            for (int r = 0; r < 3; ++r) {
                f32x4 sa = MFMA16(ka0, qf[r][0], ((f32x4){0.f, 0.f, 0.f, 0.f})); sa = MFMA16(ka1, qf[r][1], sa);
                f32x4 sb = MFMA16(kb0, qf[r][0], ((f32x4){0.f, 0.f, 0.f, 0.f})); sb = MFMA16(kb1, qf[r][1], sb);
                float mx = NEG_INF;
#pragma unroll
                for (int j = 0; j < 4; ++j) { sa[j] = (key0 + 4 * g4 + j < nvq) ? sa[j] * QSC : NEG_INF; sb[j] = (key0 + 16 + 4 * g4 + j < nvq) ? sb[j] * QSC : NEG_INF; mx = fmaxf(mx, fmaxf(sa[j], sb[j])); }
                mx = fmaxf(mx, __shfl_xor(mx, 16)); mx = fmaxf(mx, __shfl_xor(mx, 32));
                const float mn = fmaxf(m[r], mx); float ps = 0.f;
#pragma unroll
                for (int j = 0; j < 4; ++j) ps += ex2(sa[j] - mn) + ex2(sb[j] - mn);
                l[r] = l[r] * ex2(m[r] - mn) + ps; m[r] = mn;
            }
        }
        float invl[3];
#pragma unroll
        for (int r = 0; r < 3; ++r) { float lt = l[r]; lt += __shfl_xor(lt, 16); lt += __shfl_xor(lt, 32); invl[r] = lt > 0.f ? 1.0f / lt : 0.f; }
        f32x4 oc[3][4];
#pragma unroll
        for (int r = 0; r < 3; ++r)
#pragma unroll
            for (int n = 0; n < 4; ++n) oc[r][n] = (f32x4){0.f, 0.f, 0.f, 0.f};
        float imp[16];
#pragma unroll
        for (int k = 0; k < 16; ++k) imp[k] = 0.f;
        float prev_c3 = 0.f;
        const int src = (F.lane + 48) & 63;
#pragma unroll
        for (int kp_ = 0; kp_ < 8; ++kp_) {
            if (kp_ * 32 <= nvmax && nvmax > 0) {
                const int key0 = kp_ * 32;
                KVFrag f; load_kv(f, Kc, Vc, 256, key0, qi, g4);
                float own_a = 0.f, own_b = 0.f, c3a = 0.f, c3b = 0.f;
#pragma unroll
                for (int r = 0; r < 3; ++r) {
                    f32x4 sa = MFMA16(f.ka0, qf[r][0], ((f32x4){0.f, 0.f, 0.f, 0.f})); sa = MFMA16(f.ka1, qf[r][1], sa);
                    f32x4 sb = MFMA16(f.kb0, qf[r][0], ((f32x4){0.f, 0.f, 0.f, 0.f})); sb = MFMA16(f.kb1, qf[r][1], sb);
#pragma unroll
                    for (int j = 0; j < 4; ++j) {
                        sa[j] = (key0 + 4 * g4 + j < nvq) ? ex2(sa[j] * QSC - m[r]) * invl[r] : 0.f;
                        sb[j] = (key0 + 16 + 4 * g4 + j < nvq) ? ex2(sb[j] * QSC - m[r]) * invl[r] : 0.f;
                        own_a += sa[j]; own_b += sb[j]; }
                    c3a += sa[3]; c3b += sb[3];
                    const bf16x8 pf = pk8(sa, sb);
#pragma unroll
                    for (int n = 0; n < 4; ++n) oc[r][n] = MFMA16(f.vf[n], pf, oc[r][n]);
                }
                const float send_a = (g4 == 3) ? prev_c3 : c3a; imp[2 * kp_] = own_a + __shfl(send_a, src);
                const float send_b = (g4 == 3) ? c3a : c3b;     imp[2 * kp_ + 1] = own_b + __shfl(send_b, src);
                prev_c3 = c3b;
            }
            asm volatile("" ::: "memory");
        }
        float gcmp[3]; { int rw = row; NSA_LATE(rw);
#pragma unroll
            for (int r = 0; r < 3; ++r) gcmp[r] = F.GT()[(size_t)rw * 36 + (3 * g + r) * 3 + 0]; }
#pragma unroll
        for (int r = 0; r < 3; ++r)
#pragma unroll
            for (int n = 0; n < 4; ++n)
#pragma unroll
                for (int j = 0; j < 4; ++j) park[(r * 16 + n * 4 + j) * 512] = oc[r][n][j] * gcmp[r];
        __builtin_amdgcn_sched_barrier(0);
        const int cur = t >> 6;
        float sc[16]; bool causal[16];
#pragma unroll
        for (int k = 0; k < 16; ++k) { const int jb = 4 * k + g4; causal[k] = jb <= cur; const bool forced = (jb == 0) | (jb == cur) | (jb + 1 == cur);
            sc[k] = causal[k] ? imp[k] + (forced ? 1e4f : 0.f) : -1e30f; }
        bool sel[16];
#ifndef NO_RANK
        if (t0 + 15 >= 16 * 64) {
            int rank[16];
#pragma unroll
            for (int k = 0; k < 16; ++k) rank[k] = 0;
#pragma unroll 1
            for (int gs = 0; gs < 4; ++gs) {
                const bool lt = gs < g4;
#pragma unroll
                for (int ks = 0; ks < 16; ++ks) {
                    const float v = __shfl(sc[ks], qi + 16 * gs);
#pragma unroll
                    for (int k = 0; k < 16; ++k) {
                        if (ks < k) rank[k] += (v >= sc[k]) ? 1 : 0;
                        else if (ks > k) rank[k] += (v > sc[k]) ? 1 : 0;
                        else rank[k] += ((v > sc[k]) | ((v == sc[k]) & lt)) ? 1 : 0;
                    }
                }
            }
#pragma unroll
            for (int k = 0; k < 16; ++k) sel[k] = causal[k] & (rank[k] < 16);
        } else
#endif
        {
#pragma unroll
            for (int k = 0; k < 16; ++k) sel[k] = causal[k];
        }
#pragma unroll
        for (int k = 0; k < 8; ++k) { mlo |= (sel[k] ? 1u : 0u) << (4 * k + g4); mhi |= (sel[k + 8] ? 1u : 0u) << (4 * k + g4); }
        mlo |= __shfl_xor(mlo, 16); mlo |= __shfl_xor(mlo, 32); mhi |= __shfl_xor(mhi, 16); mhi |= __shfl_xor(mhi, 32);
    }
    __builtin_amdgcn_sched_barrier(0);
#ifndef NO_SEL
    {
        int bgl = bg; asm volatile("" : "+s"(bgl)); int qil = qi, g4l = g4; NSA_LATE(qil); NSA_LATE(g4l);
        const bf16* Ks = F.KSLC() + (size_t)bgl * SP * 64; const bf16* Vs = F.VTSLC() + (size_t)bgl * 64 * SP;
        Flash<3> st; st.init();
        const int jmax = (t0 + 15) >> 6;
        for (int jb = 0; jb <= jmax; ++jb) {
            const bool mine = ((jb < 32 ? (mlo >> jb) : (mhi >> (jb - 32))) & 1u) != 0u;
            if (!__any(mine)) continue;
            for (int half = 0; half < 2; ++half) { const int key0 = 64 * jb + 32 * half; if (key0 > t0 + 15) break;
                flash_step<3>(st, qf, Ks, Vs, SP, key0, qil, g4l, [&](int key) { return mine && key <= t; }); }
        }
        st.finish();
        float gsel[3]; { int rw = row; NSA_LATE(rw);
#pragma unroll
            for (int r = 0; r < 3; ++r) gsel[r] = F.GT()[(size_t)rw * 36 + (3 * g + r) * 3 + 1]; }
#pragma unroll
        for (int r = 0; r < 3; ++r)
#pragma unroll
            for (int n = 0; n < 4; ++n)
#pragma unroll
                for (int j = 0; j < 4; ++j) park[(r * 16 + n * 4 + j) * 512] += st.o[r][n][j] * gsel[r];
    }
#endif
    __builtin_amdgcn_sched_barrier(0);
#ifndef NO_WIN
    {
        int bgl = bg; asm volatile("" : "+s"(bgl)); int qil = qi, g4l = g4; NSA_LATE(qil); NSA_LATE(g4l);
        const bf16* Kw = F.KWIN() + (size_t)bgl * SP * 64; const bf16* Vw = F.VTWIN() + (size_t)bgl * 64 * SP;
        Flash<3> st; st.init();
        const int kstart = (t0 > 511 ? t0 - 511 : 0) & ~31;
        for (int key0 = kstart; key0 <= t0 + 15; key0 += 32)
            flash_step<3>(st, qf, Kw, Vw, SP, key0, qil, g4l, [&](int key) { return key <= t && key + 512 > t; });
        st.finish();
        int rw = row, g4w = g4; NSA_LATE(rw); NSA_LATE(g4w);
        float gwin[3];
#pragma unroll
        for (int r = 0; r < 3; ++r) gwin[r] = F.GT()[(size_t)rw * 36 + (3 * g + r) * 3 + 2];
#pragma unroll
        for (int r = 0; r < 3; ++r)
#pragma unroll
            for (int n = 0; n < 4; ++n) { f32x4 o;
#pragma unroll
                for (int j = 0; j < 4; ++j) o[j] = park[(r * 16 + n * 4 + j) * 512] + st.o[r][n][j] * gwin[r];
                *(u32x2*)(F.CAT() + (size_t)rw * D + (3 * g + r) * 64 + 16 * n + 4 * g4w) = pk4(o); }
    }
#endif
    __syncthreads();
}
template <int NP> struct VState { float m[NP], l[NP], o[NP];
    __device__ __forceinline__ void init() {
#pragma unroll
        for (int p = 0; p < NP; ++p) { m[p] = -1e30f; l[p] = 0.f; o[p] = 0.f; } } };
template <int NP>
__device__ __forceinline__ void valu_scores(float (&x)[NP], const LAS float* qs, const float* kptr, bool valid) {
    f32x4 kr[16];
#pragma unroll
    for (int i = 0; i < 16; ++i) kr[i] = valid ? *(const f32x4*)(kptr + 4 * i) : (f32x4){0.f, 0.f, 0.f, 0.f};
    float a[NP];
#pragma unroll
    for (int p = 0; p < NP; ++p) a[p] = 0.f;
#pragma unroll
    for (int i = 0; i < 16; ++i) {
#pragma unroll
        for (int p = 0; p < NP; ++p) { const f32x4 q = *(const LAS f32x4*)(qs + p * 64 + 4 * i); a[p] += (kr[i][0] * q[0] + kr[i][1] * q[1]) + (kr[i][2] * q[2] + kr[i][3] * q[3]); }
        asm volatile("" ::: "memory");
    }
#pragma unroll
    for (int p = 0; p < NP; ++p) x[p] = valid ? a[p] : NEG_INF;
}
template <int NP>
__device__ __forceinline__ void valu_pv(float (&o)[NP], const float (&pr)[NP], const float* vbase, int vstride, int nk, int lane) {
#pragma unroll
    for (int k0 = 0; k0 < 64; k0 += 16) {
        if (k0 < nk) {
            float v[16];
#pragma unroll
            for (int k = 0; k < 16; ++k) v[k] = (k0 + k < nk) ? vbase[(size_t)(k0 + k) * vstride + lane] : 0.f;
#pragma unroll
            for (int k = 0; k < 16; ++k)
#pragma unroll
                for (int p = 0; p < NP; ++p) o[p] += __builtin_bit_cast(float, __builtin_amdgcn_readlane(__builtin_bit_cast(int, pr[p]), k0 + k)) * v[k];
            asm volatile("" ::: "memory");
        }
    }
}
template <int NP>
__device__ __forceinline__ void valu_block(VState<NP>& st, const LAS float* qs, const float* kptr, bool valid, const float* vbase, int vstride, int nk, int lane) {
    float x[NP], pr[NP]; valu_scores<NP>(x, qs, kptr, valid);
#pragma unroll
    for (int p = 0; p < NP; ++p) { const float mx = wave_max(x[p]), mn = fmaxf(st.m[p], mx), alpha = ex2(st.m[p] - mn); st.m[p] = mn;
        pr[p] = ex2(x[p] - mn); st.l[p] = st.l[p] * alpha + wave_sum(pr[p]); st.o[p] *= alpha; }
    valu_pv<NP>(st.o, pr, vbase, vstride, nk, lane);
}
template <int NP>
__device__ __forceinline__ float valu_combine(const VState<NP>& st, LAS float* scr, int wid, int lane) {
    LAS float* wm = scr; LAS float* wl = scr + 8 * NP; LAS float* wo = scr + 16 * NP;
#pragma unroll
    for (int p = 0; p < NP; ++p) { if (lane == 0) { wm[wid * NP + p] = st.m[p]; wl[wid * NP + p] = st.l[p]; } wo[(wid * NP + p) * 64 + lane] = st.o[p]; }
    __syncthreads();
    float res = 0.f;
    if (wid < NP) { float M = -1e30f;
#pragma unroll
        for (int w = 0; w < 8; ++w) M = fmaxf(M, wm[w * NP + wid]);
        float L = 0.f, O = 0.f;
#pragma unroll
        for (int w = 0; w < 8; ++w) { const float e = ex2(wm[w * NP + wid] - M); L += wl[w * NP + wid] * e; O += wo[(w * NP + wid) * 64 + lane] * e; }
        res = L > 0.f ? O / L : 0.f; }
    __syncthreads();
    return res;
}

__device__ __forceinline__ void mem_sample_task(Frame& F, int l, int task) {
    const int hh = task & 3, b = task >> 2;
    LAS float* qs = (LAS float*)F.lds; LAS float* scr = qs + 4 * 64;
    if (F.tid < 256) { const int tt = F.tid >> 6, d = F.tid & 63; qs[F.tid] = bf2f(F.QM()[(size_t)(MP + b * 4 + tt) * MW + hh * 64 + d]) * QSC; }
    __syncthreads();
    VState<4> st; st.init();
    if (F.wid < 4) {
        const float* base = F.cache_mem() + (((size_t)(l * BS + b) * 256 + 64 * F.wid) * 2) * 256 + hh * 64;
        valu_block<4>(st, qs, base + (size_t)F.lane * 512, true, base + 256, 512, 64, F.lane);
    }
    const float o = valu_combine<4>(st, scr, F.wid, F.lane);
    if (F.wid < 4) F.CAT()[(size_t)(MP + b * 4 + F.wid) * D + AW + hh * 64 + F.lane] = (bf16)(pk2(o, 0.f) & 0xffffu);
}

__device__ __forceinline__ void nsa_sample_task(Frame& F, int task) {
    const int tt = task & 3, g = (task >> 2) & 3, b = task >> 4, row = MP + b * 4 + tt;
    LAS float* qs = (LAS float*)F.lds;
    LAS float* scr = qs + 192;
    LAS float* red = scr + 1600;
    LAS float* P3 = red + 64;
    LAS float* scl = P3 + 520;
    LAS int* slist = (LAS int*)(scl + 136);
    if (F.tid < 192) qs[F.tid] = bf2f(F.QB()[(size_t)row * AW + g * 192 + F.tid]) * QSC;
    if (F.tid < 16) slist[F.tid] = 0;
    __syncthreads();
    float gate0 = 0.f, gate1 = 0.f, gate2 = 0.f;
    if (F.wid < 3) { const float* gp = F.GT() + (size_t)row * 36 + (3 * g + F.wid) * 3; gate0 = gp[0]; gate1 = gp[1]; gate2 = gp[2]; }
    float otot = 0.f;
    {
        const int n = 64 * F.wid + F.lane; const bool valid = n < 511;
        const float* kvb = F.KVCS() + (size_t)(b * 4 + g) * 512 * 128;
        float x[3]; valu_scores<3>(x, qs, kvb + (size_t)n * 128, valid);
#pragma unroll
        for (int p = 0; p < 3; ++p) { const float mx = wave_max(x[p]); if (F.lane == 0) red[F.wid * 3 + p] = mx; }
        __syncthreads();
        float pr[3], psum = 0.f;
#pragma unroll
        for (int p = 0; p < 3; ++p) { float M = -1e30f;
#pragma unroll
            for (int w = 0; w < 8; ++w) M = fmaxf(M, red[w * 3 + p]);
            pr[p] = ex2(x[p] - M); }
        __syncthreads();
#pragma unroll
        for (int p = 0; p < 3; ++p) { const float s = wave_sum(pr[p]); if (F.lane == 0) red[F.wid * 3 + p] = s; }
        __syncthreads();
#pragma unroll
        for (int p = 0; p < 3; ++p) { float L = 0.f;
#pragma unroll
            for (int w = 0; w < 8; ++w) L += red[w * 3 + p];
            pr[p] = pr[p] / L; psum += pr[p]; }
        P3[n] = psum;
        if (F.tid < 4) P3[512 + F.tid] = 0.f;
        float o[3] = {0.f, 0.f, 0.f};
        valu_pv<3>(o, pr, kvb + (size_t)(64 * F.wid) * 128 + 64, 128, 64, F.lane);
        VState<3> st;
#pragma unroll
        for (int p = 0; p < 3; ++p) { st.m[p] = 0.f; st.l[p] = 0.125f; st.o[p] = o[p]; }
        otot += gate0 * valu_combine<3>(st, scr, F.wid, F.lane);
    }
    if (F.tid < 129) { const int j = F.tid; float im = 0.f;
#pragma unroll
        for (int i = -1; i < 4; ++i) { const int n = 4 * j + i; if (n >= 0 && n < 512) im += P3[n]; }
        scl[j] = im + ((j == 0 || j >= 127) ? 1e4f : 0.f); }
    __syncthreads();
    if (F.tid < 129) { const int j = F.tid; const float sj = scl[j]; int rank = 0;
        for (int k = 0; k < 129; ++k) { const float v = scl[k]; rank += ((v > sj) || (v == sj && k < j)) ? 1 : 0; }
        if (rank < 16) slist[rank] = j; }
    __syncthreads();
    {
        VState<3> st; st.init();
#pragma unroll 1
        for (int e = 0; e < 2; ++e) {
            const int j = slist[F.wid + 8 * e];
            if (j < 128) {
                const size_t prow = (size_t)F.page_table()[b * NPG + (j >> 1)] * 128 + (j & 1) * 64;
                const float* base = F.cache_slc() + (prow * 2) * 256 + g * 64;
                valu_block<3>(st, qs, base + (size_t)F.lane * 512, true, base + 256, 512, 64, F.lane);
            } else {
                const float* base = F.out + O_SLC_S + ((size_t)(b * 4) * 2) * 256 + g * 64;
                const bool valid = F.lane <= tt;
                valu_block<3>(st, qs, base + (size_t)(valid ? F.lane : 0) * 512, valid, base + 256, 512, 4, F.lane);
            }
        }
        otot += gate1 * valu_combine<3>(st, scr, F.wid, F.lane);
    }
    {
        VState<3> st; st.init();
        {
            const int idx = 64 * F.wid + F.lane; const bool valid = idx >= tt + 1;
            const float* base = F.cache_win() + ((size_t)(b * 512 + 64 * F.wid) * 2) * 256 + g * 64;
            valu_block<3>(st, qs, base + (size_t)F.lane * 512, valid, base + 256, 512, 64, F.lane);
        }
        if (F.wid == 0) {
            const float* base = F.out + O_WIN_S + ((size_t)(b * 512 + 508) * 2) * 256 + g * 64;
            const bool valid = F.lane <= tt;
            valu_block<3>(st, qs, base + (size_t)(valid ? F.lane : 0) * 512, valid, base + 256, 512, 4, F.lane);
        }
        otot += gate2 * valu_combine<3>(st, scr, F.wid, F.lane);
    }
    if (F.wid < 3) F.CAT()[(size_t)row * D + (3 * g + F.wid) * 64 + F.lane] = (bf16)(pk2(otot, 0.f) & 0xffffu);
}
struct ALoadCmp { const float* base; const int* pt; int c, NB, npos;
    __device__ __forceinline__ bf16x8 operator()(int row, int k) const {
        const int hh = row & 3, bn = row >> 2, n = bn % NB, b = bn / NB, s = k >> 6, d = k & 63, pos = 16 * n + s;
        if (pos >= npos) return (bf16x8){0, 0, 0, 0, 0, 0, 0, 0};
        const size_t prow = pt ? (size_t)pt[b * NPG + (pos >> 7)] * 128 + (pos & 127) : (size_t)b * SP + pos;
        const float* p = base + (prow * 2 + c) * 256 + hh * 64 + d;
        return pk8(*(const f32x4*)p, *(const f32x4*)(p + 4));
    } };
__device__ __forceinline__ void compress_unit(Frame& F, bool samp, int unit) {
    const int c = unit & 1, tile = unit >> 1, row0 = tile * 128;
    const int lane = F.lane, wid = F.wid, fr = lane & 15, fq = lane >> 4;
    LAS bf16* Hs = (LAS bf16*)F.lds;
    const float* peb = F.PEB() + c * 128;
    auto epi1 = [&](int row, int col, f32x4 v) {
        f32x4 h;
#pragma unroll
        for (int i = 0; i < 4; ++i) h[i] = gelu_t(v[i] + peb[col + i]);
        *(LAS u32x2*)(Hs + (row - row0) * 136 + col) = pk4(h);
    };
    if (samp) { ALoadCmp al{F.cache_cmp(), F.page_table(), c, 512, PAST}; sgemm_tile(F.tid, al, F.W_PHI1T() + (size_t)c * 128 * 2048, 2048, 0, 2048, row0, 0, epi1); }
    else      { ALoadCmp al{F.out + O_CMP_P, nullptr, c, 256, SP};    sgemm_tile(F.tid, al, F.W_PHI1T() + (size_t)c * 128 * 2048, 2048, 0, 2048, row0, 0, epi1); }
    __syncthreads();
    f32x4 acc[4];
#pragma unroll
    for (int n = 0; n < 4; ++n) acc[n] = (f32x4){0.f, 0.f, 0.f, 0.f};
    const bf16* W2 = F.W_PHI2T() + (size_t)c * 64 * 128;
#pragma unroll
    for (int ks = 0; ks < 4; ++ks) {
        const bf16x8 hf = *(const LAS bf16x8*)(Hs + (16 * wid + fr) * 136 + 32 * ks + 8 * fq);
#pragma unroll
        for (int n = 0; n < 4; ++n) { const bf16x8 wf = *(const bf16x8*)(W2 + (size_t)(16 * n + fr) * 128 + 32 * ks + 8 * fq); acc[n] = MFMA16(wf, hf, acc[n]); }
    }
    const int row = row0 + 16 * wid + fr, hh = row & 3, bn = row >> 2;
    if (samp) { const int n_ = bn & 511, b = bn >> 9;
#pragma unroll
        for (int n = 0; n < 4; ++n) *(f32x4*)(F.KVCS() + (((size_t)(b * 4 + hh) * 512 + n_) * 2 + c) * 64 + 16 * n + 4 * fq) = acc[n];
    } else { const int n_ = bn & 255, b = bn >> 8;
        if (n_ < 255) {
#pragma unroll
            for (int n = 0; n < 4; ++n) { const int d = 16 * n + 4 * fq; const u32x2 w = pk4(acc[n]);
                if (c == 0) *(u32x2*)(F.KCMP() + ((size_t)(b * 4 + hh) * 256 + n_) * 64 + d) = w;
                else { bf16* p = F.VTCMP() + ((size_t)(b * 4 + hh) * 64 + d) * 256 + n_; p[0] = (bf16)(w.x & 0xffffu); p[256] = (bf16)(w.x >> 16); p[512] = (bf16)(w.y & 0xffffu); p[768] = (bf16)(w.y >> 16); } }
        }
    }
    __syncthreads();
}

struct Args { const void* in[27]; float* out; unsigned char* ws; int ph_lo, ph_hi, use_bar, pad; };
constexpr int CW_BAR = 4096;

template <class F_> __device__ __forceinline__ void big_gemm(Frame& F, const bf16* A, const bf16* Bt, int N, int K, const F_& f) {
    pg8::Gemm g{A, Bt, MP, N, K}; pg8::StaticOrder S; S.init(MP, N, F.G, F.bid);
    EpiElem<F_> E{f};
    pg8::gemm_phase<EpiElem<F_>, pg8::StaticOrder, true, true>(F.lds, g, S, E, F.tid);
}
template <class F_> __device__ __forceinline__ void small_gemm(Frame& F, const bf16* A, int lda, const bf16* Bt, int N, int K, int ksplit, int row0, const F_& f) {
    const int ntn = N / 128, nun = ntn * ksplit, kc = K / ksplit;
    for (int u = F.G - 1 - F.bid; u < nun; u += F.G) { const int tn = u % ntn, ks = u / ntn; sgemm_tile(F.tid, ALoadBf16{A, lda}, Bt, K, ks * kc, (ks + 1) * kc, row0, tn * 128, f); }
}

__device__ __forceinline__ void slab_gemm(Frame& F, const bf16* A, int lda, const bf16* Bt, int N, int K, int ksplit) {
    const int ntn = N / 128, nun = ntn * ksplit, kc = K / ksplit;
    for (int u = F.G - 1 - F.bid; u < nun; u += F.G) { const int tn = u % ntn, ks = u / ntn; sgemm_tile(F.tid, ALoadBf16{A, lda}, Bt, K, ks * kc, (ks + 1) * kc, MP, tn * 128, FSlab{F.ZS() + (size_t)ks * MS * D}); }
}

__global__ void __launch_bounds__(512, 2) yoco_fwd(Args args) {
    extern __shared__ __attribute__((aligned(16))) unsigned char lds_raw[];
    Frame F;
    F.lds = (LAS unsigned char*)lds_raw; F.tid = threadIdx.x; F.lane = F.tid & 63; F.wid = __builtin_amdgcn_readfirstlane(F.tid >> 6); F.G = gridDim.x; F.bid = blockIdx.x;
    F.out = args.out; F.ws = args.ws;
    unsigned char* ws = args.ws;
    volatile LAS unsigned* MISC = (volatile LAS unsigned*)(F.lds + MISC_OFF);
    for (int u = F.tid; u < (LDS_BYTES - 131072) / 4; u += 512) ((LAS unsigned*)(F.lds + 131072))[u] = 0u;
    __syncthreads();
    if (F.tid == 0) { LAS unsigned long long* ip = (LAS unsigned long long*)(F.lds + INPTR_OFF);
#pragma unroll
        for (int i = 0; i < 27; ++i) ip[i] = (unsigned long long)args.in[i]; }
    __syncthreads();
    XcdBarrier bar; bar.bar = (unsigned*)(ws + WS_CTL) + CW_BAR; bar.x = 0; bar.st = nullptr;
    if (args.use_bar) bar = xcd_barrier_post((unsigned*)(ws + WS_CTL) + CW_BAR, MISC + 8);
    const int lo = args.ph_lo, hi = args.ph_hi; int pc = 0;
#define RELANE(F) do { int t_ = threadIdx.x; asm volatile("" : "+v"(t_)); F.tid = t_; F.lane = t_ & 63; F.wid = __builtin_amdgcn_readfirstlane(t_ >> 6); } while (0)
#define PHASE_BEGIN if (lo <= pc && pc < hi) { { int t_ = threadIdx.x; asm volatile("" : "+v"(t_)); F.tid = t_; F.lane = t_ & 63; F.wid = __builtin_amdgcn_readfirstlane(t_ >> 6); \
      int b_ = blockIdx.x; asm volatile("" : "+s"(b_)); F.bid = b_; unsigned char* w_ = args.ws; asm volatile("" : "+s"(w_)); F.ws = w_; float* o_ = args.out; asm volatile("" : "+s"(o_)); F.out = o_; }
#define PHASE_END   if (pc + 1 < hi && args.use_bar) xcd_barrier(bar); } ++pc;

    PHASE_BEGIN p_prologue(F); PHASE_END
    for (int l = 0; l < 4; ++l) {
        const bool isA = l < 2; const int li = l & 1;
        PHASE_BEGIN
        if (isA) {
            FInA f{F.U(), F.VP(), F.QM()};
            big_gemm(F, F.XB(), F.W_INA() + (size_t)li * NIA * D, NIA, D, f);
            small_gemm(F, F.XB(), D, F.W_INA() + (size_t)li * NIA * D, NIA, D, 1, MP, f);
            if (l == 0) {
                FMemKV fm{F.out + O_MEM_P, F.KMEM(), F.VTMEM()};
                struct ALoadF32 { const float* A; __device__ __forceinline__ bf16x8 operator()(int row, int k) const { const float* p = A + (size_t)row * D + k; return pk8(*(const f32x4*)p, *(const f32x4*)(p + 4)); } };
                for (int u = F.bid; u < 8 * 16; u += F.G) sgemm_tile(F.tid, ALoadF32{F.mem_prompt()}, F.W_MEM(), D, 0, D, (u & 7) * 128, (u >> 3) * 128, fm);
            }
        } else {
            FInB f{F.ROPE(), F.QB(), F.QM(), F.GT()};
            big_gemm(F, F.XB(), F.W_INB() + (size_t)li * NIBP * D, NIBP, D, f);
            small_gemm(F, F.XB(), D, F.W_INB() + (size_t)li * NIBP * D, NIBP, D, 1, MP, f);
            if (l == 2) {
                FKV fk{F.ROPE(), F.out, F.KSLC(), F.VTSLC(), F.KWIN(), F.VTWIN(), O_CMP_P, O_SLC_P, O_WIN_P, O_CMP_S, O_SLC_S, O_WIN_S};
                big_gemm(F, F.XB(), F.W_KV(), NKV, D, fk);
                small_gemm(F, F.XB(), D, F.W_KV(), NKV, D, 1, MP, fk);
            }
        }
        PHASE_END
        if (l == 2) {
            PHASE_BEGIN
            for (int u = F.bid; u < 1024 + 64; u += F.G) { RELANE(F); if (u < 1024) compress_unit(F, true, u); else compress_unit(F, false, u - 1024); }
            PHASE_END
        }
        PHASE_BEGIN
        if (isA) {
            for (int u = F.bid; u < 640 + 512 + 128; u += F.G) {
                RELANE(F);
                if (u < 640) spatial_unit(F, l, u); else if (u < 1152) mem_prompt_unit(F, l, u - 640); else mem_sample_task(F, l, u - 1152);
            }
        } else {
            for (int u = F.bid; u < 512 + 512 + 512 + 128; u += F.G) {
                RELANE(F);
                if (u < 512) nsa_prompt_unit(F, u); else if (u < 1024) nsa_sample_task(F, u - 512); else if (u < 1536) mem_prompt_unit(F, l, u - 1024); else mem_sample_task(F, l, u - 1536);
            }
        }
        PHASE_END
        PHASE_BEGIN
        { const bf16* W = (isA ? F.W_OUTA() : F.W_OUTB()) + (size_t)li * D * D;
          big_gemm(F, F.CAT(), W, D, D, FRes{F.XRES(), F.Z()});
          slab_gemm(F, F.CAT(), D, W, D, D, 4);
        }
        PHASE_END
        PHASE_BEGIN ln_pass(F, F.ln1_g() + l * D, F.ln1_b() + l * D, 4, F.XRES(), F.XRES() + (size_t)MP * D, F.XB()); PHASE_END
        PHASE_BEGIN
        { FUp f{F.HB()}; big_gemm(F, F.XB(), F.W_UP() + (size_t)l * FF * D, FF, D, f); small_gemm(F, F.XB(), D, F.W_UP() + (size_t)l * FF * D, FF, D, 1, MP, f); }
        PHASE_END
        PHASE_BEGIN
        { const bf16* W = F.W_DOWN() + (size_t)l * D * FF;
          big_gemm(F, F.HB(), W, D, FF, FRes{F.XRES(), F.Z()});
          slab_gemm(F, F.HB(), FF, W, D, FF, 8); }
        PHASE_END
        PHASE_BEGIN
        if (l < 3) ln_pass(F, F.ln2_g() + l * D, F.ln2_b() + l * D, 8, F.XRES(), F.XRES() + (size_t)MP * D, F.XB());
        else       ln_pass(F, F.ln2_g() + l * D, F.ln2_b() + l * D, 8, F.out + O_Y_P, F.out + O_Y_S, nullptr);
        PHASE_END
    }
}

constexpr int NPHASES = 1 + 4 * 7 + 1;
static_assert(O_END == 45547520, "output size");
#ifndef MK_PER_PHASE
#define MK_PER_PHASE 0
#endif
extern "C" void kernel_launch(void* const* d_in, const int* in_sizes, int n_in, void* d_out, int out_size, void* d_ws, size_t ws_size, hipStream_t stream) {
    static int grid = 0;
    if (grid == 0) {
        if (n_in != 27 || (size_t)out_size != O_END || ws_size < WS_END) { fprintf(stderr, "kernel_launch: unexpected shapes (n_in %d, out %d, ws %zu; need 27, %zu, >= %zu)\n", n_in, out_size, ws_size, (size_t)O_END, (size_t)WS_END); grid = -1; return; }
        int dev = 0, cus = 0, per_cu = 0;
        if (hipGetDevice(&dev) != hipSuccess || hipDeviceGetAttribute(&cus, hipDeviceAttributeMultiprocessorCount, dev) != hipSuccess) { grid = -1; return; }
        if (hipFuncSetAttribute((const void*)yoco_fwd, hipFuncAttributeMaxDynamicSharedMemorySize, LDS_BYTES) != hipSuccess) { fprintf(stderr, "kernel_launch: hipFuncSetAttribute failed\n"); grid = -1; return; }
        if (hipOccupancyMaxActiveBlocksPerMultiprocessor(&per_cu, (const void*)yoco_fwd, 512, LDS_BYTES) != hipSuccess || per_cu < 1) { fprintf(stderr, "kernel_launch: occupancy query says %d blocks per CU\n", per_cu); (void)hipGetLastError(); }
        grid = cus;
    }
    if (grid < 0) return;
    (void)hipMemsetAsync((char*)d_ws + WS_CTL, 0, CTL_BYTES, stream);
    Args a{};
    for (int i = 0; i < 27; ++i) a.in[i] = d_in[i];
    a.out = (float*)d_out; a.ws = (unsigned char*)d_ws; a.pad = 0;
#if MK_PER_PHASE
    for (int p = 0; p < NPHASES; ++p) { a.ph_lo = p; a.ph_hi = p + 1; a.use_bar = 0; hipLaunchKernelGGL(yoco_fwd, dim3(grid), dim3(512), LDS_BYTES, stream, a); }
#else
    a.ph_lo = 0; a.ph_hi = NPHASES; a.use_bar = 1;
    hipLaunchKernelGGL(yoco_fwd, dim3(grid), dim3(512), LDS_BYTES, stream, a);
#endif
    const hipError_t le = hipPeekAtLastError();
    if (le != hipSuccess) fprintf(stderr, "kernel_launch: launch failed: %s\n", hipGetErrorName(le));
}
```

```cpp
#include <hip/hip_runtime.h>
#include <cstdio>
#include <cstdint>

#define LAS __attribute__((address_space(3)))
typedef unsigned short bf16;
typedef short bf16x8 __attribute__((ext_vector_type(8)));
typedef float f32x4 __attribute__((ext_vector_type(4)));
typedef float f32x2 __attribute__((ext_vector_type(2)));
typedef unsigned u32x4 __attribute__((ext_vector_type(4)));
typedef unsigned u32x2 __attribute__((ext_vector_type(2)));
typedef __bf16 bf16x2_t __attribute__((ext_vector_type(2)));

constexpr int D = 1024, BP = 4, SP = 4096, MP = BP * SP, BS = 32, TS = 4, MS = BS * TS, MT = MP + MS;
constexpr int AW = 768, MW = 256, NIA = 1792, NIB = 1060, NIBP = 1280, NKV = 1536, FF = 4096;
constexpr int PAST = 8192, NPG = 64;
constexpr float ALPHA = 1.6817928305074292f;
constexpr float LN_EPS = 1e-5f;
constexpr float QSC = 0.125f * 1.4426950408889634f;
constexpr float NEG_INF = -__builtin_inff();

__device__ __forceinline__ unsigned pk2(float lo, float hi) { f32x2 v = {lo, hi}; bf16x2_t b = __builtin_convertvector(v, bf16x2_t); return __builtin_bit_cast(unsigned, b); }
__device__ __forceinline__ float bf2f(unsigned short h) { return __uint_as_float(((unsigned)h) << 16); }
__device__ __forceinline__ u32x2 pk4(f32x4 v) { u32x2 r; r.x = pk2(v[0], v[1]); r.y = pk2(v[2], v[3]); return r; }
__device__ __forceinline__ bf16x8 pk8(f32x4 a, f32x4 b) { u32x4 r; r.x = pk2(a[0], a[1]); r.y = pk2(a[2], a[3]); r.z = pk2(b[0], b[1]); r.w = pk2(b[2], b[3]); return __builtin_bit_cast(bf16x8, r); }
__device__ __forceinline__ float ex2(float x) { return __builtin_amdgcn_exp2f(x); }
__device__ __forceinline__ float rcp(float x) { return __builtin_amdgcn_rcpf(x); }
__device__ __forceinline__ float gelu_t(float x) {
    const float u = 0.7978845608028654f * (x + 0.044715f * x * x * x);
    return x * rcp(1.0f + ex2(-2.0f * 1.4426950408889634f * u));
}
__device__ __forceinline__ float sigmoid_f(float x) { return rcp(1.0f + ex2(-1.4426950408889634f * x)); }
__device__ __forceinline__ float wave_sum(float v) {
#pragma unroll
    for (int o = 1; o < 64; o <<= 1) v += __shfl_xor(v, o);
    return v;
}
__device__ __forceinline__ float wave_max(float v) {
#pragma unroll
    for (int o = 1; o < 64; o <<= 1) v = fmaxf(v, __shfl_xor(v, o));
    return v;
}
#define MFMA16(a, b, c) __builtin_amdgcn_mfma_f32_16x16x32_bf16((a), (b), (c), 0, 0, 0)
#define LDS_WAIT() asm volatile("s_waitcnt lgkmcnt(0)" ::: "memory")

#define XB_TMO      128
#define XB_XCNT(j)  (256  + 64 * (j))
#define XB_XSUB(j)  (1280 + 64 * (j))
#define XB_XGEN(j)  (2304 + 64 * (j))
#define XB_TOP      3328
#define XB_TOPGEN   3392
#define XCD_BAR_WORDS 3456
#define XB_SPIN_CAP (1u << 22)
__device__ __forceinline__ unsigned xb_ld(unsigned* p)              { return __hip_atomic_load(p, __ATOMIC_RELAXED, __HIP_MEMORY_SCOPE_AGENT); }
__device__ __forceinline__ unsigned xb_add(unsigned* p, unsigned v) { return __hip_atomic_fetch_add(p, v, __ATOMIC_RELAXED, __HIP_MEMORY_SCOPE_AGENT); }
__device__ __forceinline__ unsigned xb_xcc_id() { return (unsigned)__builtin_amdgcn_s_getreg((3 << 11) | 20) & 0xFu; }
#define XB_SPIN(cond, bar) do { unsigned _sp = 0; while (cond) { __builtin_amdgcn_s_sleep(1); \
    if ((++_sp & 255u) == 0u) { if (xb_ld(&(bar)[XB_TMO])) break; if (_sp > XB_SPIN_CAP) { atomicAdd(&(bar)[XB_TMO], 1u); break; } } } } while (0)
struct XcdBarrier { unsigned* bar; unsigned x; volatile LAS unsigned* st; };
__device__ __forceinline__ XcdBarrier xcd_barrier_post(unsigned* bar, volatile LAS unsigned* st) {
    XcdBarrier b; b.bar = bar; b.x = xb_xcc_id(); b.st = st;
    if (threadIdx.x == 0) (void)xb_add(&bar[XB_XCNT(b.x)], 1u);
    return b;
}
__device__ __forceinline__ void xcd_barrier_complete(unsigned* bar, unsigned x, unsigned& nloc, unsigned& nx) {
    const unsigned G = gridDim.x * gridDim.y * gridDim.z;
    unsigned sum, cnt, mine, sp = 0u;
    for (;;) {
        sum = 0u; cnt = 0u; mine = 0u;
#pragma unroll
        for (unsigned j = 0; j < 16; ++j) { const unsigned c = xb_ld(&bar[XB_XCNT(j)]); sum += c; cnt += (c > 0u) ? 1u : 0u; mine = (j == x) ? c : mine; }
        if (sum == G) break;
        __builtin_amdgcn_s_sleep(1);
        if ((++sp & 255u) == 0u) { if (xb_ld(&bar[XB_TMO])) break; if (sp > XB_SPIN_CAP) { atomicAdd(&bar[XB_TMO], 1u); break; } }
    }
    nloc = mine > 0u ? mine : 1u; nx = cnt > 0u ? cnt : 1u;
}
__device__ __forceinline__ void xcd_barrier(const XcdBarrier& b) {
    asm volatile("s_waitcnt vmcnt(0)" ::: "memory");
    __syncthreads();
    if (threadIdx.x == 0) {
        unsigned* bar = b.bar;
        __builtin_amdgcn_s_waitcnt(0);
        unsigned nloc = b.st[0], nx = b.st[1];
        if (nloc == 0u) { xcd_barrier_complete(bar, b.x, nloc, nx); b.st[0] = nloc; b.st[1] = nx; }
        const unsigned old = xb_add(&bar[XB_XSUB(b.x)], 1u);
        const unsigned gen = old / nloc;
        if (old + 1u == (gen + 1u) * nloc) {
            __builtin_amdgcn_fence(__ATOMIC_RELEASE, "agent");
            asm volatile("s_waitcnt vmcnt(0)" ::: "memory");
            const unsigned og = xb_add(&bar[XB_TOP], 1u);
            const unsigned tg = og / nx;
            if (og + 1u == (tg + 1u) * nx) xb_add(&bar[XB_TOPGEN], 1u);
            else XB_SPIN(xb_ld(&bar[XB_TOPGEN]) == tg, bar);
            __builtin_amdgcn_fence(__ATOMIC_ACQUIRE, "agent");
            xb_add(&bar[XB_XGEN(b.x)], 1u);
            asm volatile("s_waitcnt vmcnt(0)" ::: "memory");
        } else {
            XB_SPIN(xb_ld(&bar[XB_XGEN(b.x)]) == gen, bar);
            __builtin_amdgcn_fence(__ATOMIC_ACQUIRE, "agent");
            asm volatile("s_waitcnt vmcnt(0)" ::: "memory");
        }
    }
    __syncthreads();
}

namespace pg8 {
#define PG8_LAS __attribute__((address_space(3)))
typedef unsigned short bf16_t;
constexpr int BM = 256, BK = 64, HALF = 128, HTB = HALF * BK * 2  , STAGE_BYTES = 8 * HTB, NXCD = 8, WGM = 8;

__host__ __device__ __forceinline__ int lds_byte(int r, int c) { const int st = (r >> 4) * 2 + (c >> 5), rr = r & 15, cc = c & 31, ob = rr * 64 + cc * 2; return st * 1024 + (ob ^ (((ob >> 9) & 1) << 5)); }
__host__ __device__ __forceinline__ void stage_rc(int b, int& R, int& C) { const int st = b / 1024, sb = b % 1024, swz = sb ^ (((sb >> 9) & 1) << 5); R = (st >> 1) * 16 + swz / 64; C = (st & 1) * 32 + (swz % 64) / 2; }
__host__ __device__ __forceinline__ int perm32(int rho) { const int n = rho >> 4, i = rho & 15; return 8 * (i >> 2) + 4 * n + (i & 3); }

struct Unit { int pm, pn; };
struct Gemm { const bf16_t* A; const bf16_t* Bt; int M, N, K; };

struct StaticOrder {
    int nM, nN, nwg, G, c;
    __host__ __device__ void init(int M, int N, int G_, int c_) { nM = M / BM; nN = N / BM; nwg = nM * nN; G = G_; c = c_; }
    __host__ __device__ bool next(int i, Unit& u) const {
        const long L = (long)i * G + c; if (L >= nwg) return false;
        int wgid = (int)L; { const int q = nwg / NXCD, r = nwg % NXCD, xcd = wgid % NXCD, off = wgid / NXCD; wgid = (xcd < r ? xcd * (q + 1) : r * (q + 1) + (xcd - r) * q) + off; }
        const int nig = WGM * nN, gid = wgid / nig, fm = gid * WGM, gsz = (nM - fm) < WGM ? (nM - fm) : WGM;
        u.pm = fm + ((wgid % nig) % gsz); u.pn = (wgid % nig) / gsz; return true;
    }
    __device__ __forceinline__ void a_ready(const Unit&) const {}
    __device__ __forceinline__ void done(const Unit&) const {}
};

template <class Epi, class Sched, bool ALIGN_EPI = false, bool SP2 = false>
__device__ __forceinline__ void gemm_phase(PG8_LAS unsigned char* lds, const Gemm g, const Sched& S, const Epi& E, const int tid) {
    const int wid = __builtin_amdgcn_readfirstlane(tid >> 6), lane = tid & 63, wr = wid >> 2, wc = wid & 3, fr = lane & 15, fq = lane >> 4;
    const int K = g.K, nt = K / BK;
    unsigned voffA[2], voffB[2];
#pragma unroll
    for (int i = 0; i < 2; ++i) { int R, C; stage_rc(tid * 16 + i * 8192, R, C); const int Rb = Epi::PERM ? ((R & ~31) + perm32(R & 31)) : R;
        voffA[i] = (unsigned)(R * K + C) * 2u; voffB[i] = (unsigned)(Rb * K + C) * 2u; }
    const size_t kstep = (size_t)(BK * 2);
    const size_t hstep = (size_t)HALF * K * 2;
    const size_t tstep = 2 * hstep;
    const unsigned ldsw = (unsigned)wid * 1024u;
    const int aoff = lds_byte(wr * 64 + fr, fq * 8), boff = lds_byte(wc * 32 + fr, fq * 8);
#define PG8_SA(b, h) (((b) * 2 + (h)) * HTB)
#define PG8_SB(b, h) ((4 + (b) * 2 + (h)) * HTB)
#define PG8_STAGE(bufoff, gbase, voff) do { _Pragma("unroll") for (int _i = 0; _i < 2; ++_i) \
        __builtin_amdgcn_global_load_lds((const unsigned*)((const char*)(gbase) + (voff)[_i]), (PG8_LAS unsigned*)(lds + (bufoff) + ldsw + _i * 8192), 16, 0, 0); } while (0)
#define PG8_LDA(dst, b, h) do { _Pragma("unroll") for (int m = 0; m < 4; ++m) _Pragma("unroll") for (int k = 0; k < 2; ++k) dst[m][k] = *(const PG8_LAS bf16x8*)(lds + PG8_SA(b, h) + aoff + m * 2048 + k * 1024); } while (0)
#define PG8_LDB(dst, b, h) do { _Pragma("unroll") for (int n = 0; n < 2; ++n) _Pragma("unroll") for (int k = 0; k < 2; ++k) dst[n][k] = *(const PG8_LAS bf16x8*)(lds + PG8_SB(b, h) + boff + n * 2048 + k * 1024); } while (0)
#define PG8_MMA(ai, bj, At, Bt) do { __builtin_amdgcn_s_setprio(1); _Pragma("unroll") for (int m = 0; m < 4; ++m) _Pragma("unroll") for (int n = 0; n < 2; ++n) _Pragma("unroll") for (int k = 0; k < 2; ++k) \
        acc[ai][bj][m][n] = __builtin_amdgcn_mfma_f32_16x16x32_bf16(Bt[n][k], At[m][k], acc[ai][bj][m][n], 0, 0, 0); __builtin_amdgcn_s_setprio(0); } while (0)
#define PG8_WAIT_V(n) asm volatile("s_waitcnt vmcnt(" #n ")" ::: "memory")
#define PG8_WAIT_L(n) asm volatile("s_waitcnt lgkmcnt(" #n ")" ::: "memory")
#define PG8_BAR __builtin_amdgcn_s_barrier()
#define PG8_SCHED __builtin_amdgcn_sched_barrier(0)
    Unit cur, nxt; int ui = 0;
    if (!S.next(0, cur)) return;
    f32x4 acc[2][2][4][2];
#pragma unroll
    for (int a = 0; a < 2; ++a)
#pragma unroll
        for (int b = 0; b < 2; ++b)
#pragma unroll
            for (int m = 0; m < 4; ++m)
#pragma unroll
                for (int n = 0; n < 2; ++n) acc[a][b][m][n] = (f32x4){0.f, 0.f, 0.f, 0.f};
    bf16x8 At[4][2], B0[2][2], B1[2][2];
    const char* cA = (const char*)g.A + (size_t)cur.pm * tstep; const char* cB = (const char*)g.Bt + (size_t)cur.pn * tstep;
    S.a_ready(cur);
    if constexpr (SP2) {
        PG8_STAGE(PG8_SB(0, 0), cB, voffB); PG8_STAGE(PG8_SB(0, 1), cB + hstep, voffB); PG8_STAGE(PG8_SA(0, 0), cA, voffA); PG8_STAGE(PG8_SA(0, 1), cA + hstep, voffA);
        if (wr == 1) PG8_BAR;
        PG8_WAIT_V(2); PG8_BAR;
        PG8_STAGE(PG8_SB(1, 0), cB + kstep, voffB); PG8_STAGE(PG8_SA(1, 0), cA + kstep, voffA); PG8_STAGE(PG8_SB(1, 1), cB + hstep + kstep, voffB);
        PG8_WAIT_V(6); PG8_BAR;
    } else {
        PG8_STAGE(PG8_SB(0, 0), cB, voffB); PG8_STAGE(PG8_SA(0, 0), cA, voffA); PG8_STAGE(PG8_SB(0, 1), cB + hstep, voffB); PG8_STAGE(PG8_SA(0, 1), cA + hstep, voffA);
        if (wr == 1) PG8_BAR;
        PG8_WAIT_V(4); PG8_BAR;
        PG8_STAGE(PG8_SB(1, 0), cB + kstep, voffB); PG8_STAGE(PG8_SA(1, 0), cA + kstep, voffA); PG8_STAGE(PG8_SB(1, 1), cB + hstep + kstep, voffB);
        PG8_WAIT_V(6); PG8_BAR;
    }
    for (;;) {
        const bool has_next = S.next(ui + 1, nxt);
        const char* nA = has_next ? (const char*)g.A + (size_t)nxt.pm * tstep : cA; const char* nB = has_next ? (const char*)g.Bt + (size_t)nxt.pn * tstep : cB;
        for (int t = 0; t < nt; t += 2) {
            const bool last = (t == nt - 2);
            const char* a1 = cA + (size_t)(t + 1) * kstep;
            const char* a2 = last ? nA : cA + (size_t)(t + 2) * kstep; const char* b2 = last ? nB : cB + (size_t)(t + 2) * kstep;
            const char* a3 = a2 + kstep; const char* b3 = b2 + kstep;
            if (last && has_next) S.a_ready(nxt);
            if constexpr (SP2) {
            PG8_LDB(B0, 0, 0); PG8_LDB(B1, 0, 1); PG8_SCHED; PG8_LDA(At, 0, 0); PG8_STAGE(PG8_SA(1, 1), a1 + hstep, voffA);
            PG8_WAIT_V(8); PG8_WAIT_L(0); PG8_BAR; PG8_MMA(0, 0, At, B0); PG8_MMA(0, 1, At, B1); PG8_BAR; PG8_SCHED;
            PG8_LDA(At, 0, 1); PG8_STAGE(PG8_SB(0, 0), b2, voffB); PG8_STAGE(PG8_SB(0, 1), b2 + hstep, voffB); PG8_STAGE(PG8_SA(0, 0), a2, voffA);
            PG8_WAIT_V(8); PG8_WAIT_L(0); PG8_BAR; PG8_MMA(1, 0, At, B0); PG8_MMA(1, 1, At, B1); PG8_BAR; PG8_SCHED;
            PG8_LDB(B0, 1, 0); PG8_LDB(B1, 1, 1); PG8_SCHED; PG8_LDA(At, 1, 0); PG8_STAGE(PG8_SA(0, 1), a2 + hstep, voffA);
            PG8_WAIT_V(8); PG8_WAIT_L(0); PG8_BAR; PG8_MMA(0, 0, At, B0); PG8_MMA(0, 1, At, B1); PG8_BAR; PG8_SCHED;
            PG8_LDA(At, 1, 1); PG8_STAGE(PG8_SB(1, 0), b3, voffB); PG8_STAGE(PG8_SB(1, 1), b3 + hstep, voffB); PG8_STAGE(PG8_SA(1, 0), a3, voffA);
            PG8_WAIT_V(8); PG8_WAIT_L(0); PG8_BAR; PG8_MMA(1, 0, At, B0); PG8_MMA(1, 1, At, B1); PG8_BAR; PG8_SCHED;
            } else {
            PG8_LDB(B0, 0, 0); PG8_SCHED; PG8_LDA(At, 0, 0); PG8_STAGE(PG8_SA(1, 1), a1 + hstep, voffA);
            PG8_WAIT_L(8); PG8_BAR; PG8_WAIT_L(0); PG8_MMA(0, 0, At, B0); PG8_BAR; PG8_SCHED;
            PG8_LDB(B1, 0, 1); PG8_STAGE(PG8_SB(0, 0), b2, voffB);
            PG8_BAR; PG8_WAIT_L(0); PG8_MMA(0, 1, At, B1); PG8_BAR;
            PG8_LDA(At, 0, 1); PG8_STAGE(PG8_SA(0, 0), a2, voffA);
            PG8_BAR; PG8_WAIT_L(0); PG8_MMA(1, 0, At, B0); PG8_BAR; PG8_SCHED;
            PG8_STAGE(PG8_SB(0, 1), b2 + hstep, voffB);
            PG8_WAIT_V(6); PG8_BAR; PG8_MMA(1, 1, At, B1); PG8_BAR;
            PG8_LDB(B0, 1, 0); PG8_SCHED; PG8_LDA(At, 1, 0); PG8_STAGE(PG8_SA(0, 1), a2 + hstep, voffA);
            PG8_WAIT_L(8); PG8_BAR; PG8_WAIT_L(0); PG8_MMA(0, 0, At, B0); PG8_BAR; PG8_SCHED;
            PG8_LDB(B1, 1, 1); PG8_STAGE(PG8_SB(1, 0), b3, voffB);
            PG8_BAR; PG8_WAIT_L(0); PG8_MMA(0, 1, At, B1); PG8_BAR;
            PG8_LDA(At, 1, 1); PG8_STAGE(PG8_SA(1, 0), a3, voffA);
            PG8_BAR; PG8_WAIT_L(0); PG8_MMA(1, 0, At, B0); PG8_BAR; PG8_SCHED;
            PG8_STAGE(PG8_SB(1, 1), b3 + hstep, voffB);
            PG8_WAIT_V(6); PG8_BAR; PG8_MMA(1, 1, At, B1); PG8_BAR;
            }
        }
        if constexpr (ALIGN_EPI) { if (wr == 0) PG8_BAR; }
        if constexpr (!Epi::AFTER_DRAIN) { E(acc, cur, wr, wc, fr, fq); S.done(cur); }
        if (!has_next) break;
#pragma unroll
        for (int a = 0; a < 2; ++a)
#pragma unroll
            for (int b = 0; b < 2; ++b)
#pragma unroll
                for (int m = 0; m < 4; ++m)
#pragma unroll
                    for (int n = 0; n < 2; ++n) acc[a][b][m][n] = (f32x4){0.f, 0.f, 0.f, 0.f};
        cur = nxt; cA = nA; cB = nB; ++ui;
        if constexpr (ALIGN_EPI) { if (wr == 1) PG8_BAR; }
    }
    PG8_WAIT_V(0);
    if constexpr (!ALIGN_EPI) { if (wr == 0) PG8_BAR; }
    PG8_BAR;
    if constexpr (Epi::AFTER_DRAIN) { E.fused(acc, cur, wr, wc, fr, fq, lds, wid, lane); S.done(cur); }
#undef PG8_SA
#undef PG8_SB
#undef PG8_STAGE
#undef PG8_LDA
#undef PG8_LDB
#undef PG8_MMA
#undef PG8_WAIT_V
#undef PG8_WAIT_L
#undef PG8_BAR
#undef PG8_SCHED
}
}
template <class F> struct EpiElem { static constexpr bool PERM = false, AFTER_DRAIN = false; F f;
    __device__ __forceinline__ void operator()(const f32x4 (&acc)[2][2][4][2], const pg8::Unit& u, int wr, int wc, int fr, int fq) const {
#pragma unroll
        for (int ai = 0; ai < 2; ++ai)
#pragma unroll
            for (int m = 0; m < 4; ++m)
#pragma unroll
                for (int bj = 0; bj < 2; ++bj)
#pragma unroll
                    for (int n = 0; n < 2; ++n) f(u.pm * 256 + ai * 128 + wr * 64 + m * 16 + fr, u.pn * 256 + bj * 128 + wc * 32 + n * 16 + 4 * fq, acc[ai][bj][m][n]);
    } };

struct ALoadBf16 { const bf16* A; int lda; __device__ __forceinline__ bf16x8 operator()(int row, int k) const { return *(const bf16x8*)(A + (size_t)row * lda + k); } };
template <class AL, class E>
__device__ __forceinline__ void sgemm_tile(int tid, const AL& al, const bf16* Bt, int ldb, int k0, int k1, int row0, int col0, const E& epi) {
    const int lane = tid & 63, wid = tid >> 6, fr = lane & 15, fq = lane >> 4, wm = wid >> 1, wn = wid & 1;
    const int ar = row0 + wm * 32 + fr, bc = col0 + wn * 64 + fr;
    f32x4 acc[2][4];
#pragma unroll
    for (int i = 0; i < 2; ++i)
#pragma unroll
        for (int j = 0; j < 4; ++j) acc[i][j] = (f32x4){0.f, 0.f, 0.f, 0.f};
    const bf16* bp = Bt + (size_t)bc * ldb + 8 * fq;
#pragma unroll 2
    for (int k = k0; k < k1; k += 32) {
        bf16x8 af[2], bf_[4];
#pragma unroll
        for (int i = 0; i < 2; ++i) af[i] = al(ar + 16 * i, k + 8 * fq);
#pragma unroll
        for (int j = 0; j < 4; ++j) bf_[j] = *(const bf16x8*)(bp + (size_t)(16 * j) * ldb + k);
#pragma unroll
        for (int i = 0; i < 2; ++i)
#pragma unroll
            for (int j = 0; j < 4; ++j) acc[i][j] = MFMA16(bf_[j], af[i], acc[i][j]);
    }
#pragma unroll
    for (int i = 0; i < 2; ++i)
#pragma unroll
        for (int j = 0; j < 4; ++j) epi(ar + 16 * i, col0 + wn * 64 + 16 * j + 4 * fq, acc[i][j]);
}

struct FInA {
    bf16 *U, *VP, *QM;
    __device__ __forceinline__ void operator()(int row, int col, f32x4 v) const {
        if (col < 2 * AW) {
            f32x4 gl; gl[0] = gelu_t(v[0]); gl[1] = gelu_t(v[1]); gl[2] = gelu_t(v[2]); gl[3] = gelu_t(v[3]);
            bf16* dst = col < AW ? U + (size_t)row * AW + col : VP + (size_t)row * AW + (col - AW);
            *(u32x2*)dst = pk4(gl);
        } else *(u32x2*)(QM + (size_t)row * MW + (col - 2 * AW)) = pk4(v);
    } };
struct FRes {
    const float* X; float* Z;
    __device__ __forceinline__ void operator()(int row, int col, f32x4 v) const {
        const size_t o = (size_t)row * D + col; const f32x4 x = *(const f32x4*)(X + o); *(f32x4*)(Z + o) = x * ALPHA + v;
    } };
struct FSlab {
    float* ZS;
    __device__ __forceinline__ void operator()(int row, int col, f32x4 v) const { *(f32x4*)(ZS + (size_t)(row - MP) * D + col) = v; } };
struct FUp {
    bf16* H;
    __device__ __forceinline__ void operator()(int row, int col, f32x4 v) const {
        f32x4 r;
#pragma unroll
        for (int i = 0; i < 4; ++i) { const float t = fmaxf(v[i], 0.f); r[i] = t * t; }
        *(u32x2*)(H + (size_t)row * FF + col) = pk4(r);
    } };
__device__ __forceinline__ f32x4 rope4(f32x4 v, f32x4 partner, const float* rope, int posidx, int d) {
    const float* rp = rope + (size_t)posidx * 16 + (d & 7);
    const f32x4 cs = *(const f32x4*)rp, sn = *(const f32x4*)(rp + 8);
    return (d & 8) ? v * cs + partner * sn : v * cs - partner * sn;
}
__device__ __forceinline__ f32x4 shfl_xor4(f32x4 v, int m) { f32x4 r; r[0] = __shfl_xor(v[0], m); r[1] = __shfl_xor(v[1], m); r[2] = __shfl_xor(v[2], m); r[3] = __shfl_xor(v[3], m); return r; }
struct FKV {
    const float* rope; float* out;
    bf16 *KS, *VTS, *KW, *VTW;
    size_t o_cmp_p, o_slc_p, o_win_p, o_cmp_s, o_slc_s, o_win_s;
    __device__ __forceinline__ void operator()(int row, int col, f32x4 v) const {
        const int br = col >> 9, cc = col & 511, c = (cc >> 8) & 1, hh = (cc >> 6) & 3, d = cc & 63;
        const bool prompt = row < MP;
        int b, t, posidx;
        if (prompt) { b = row >> 12; t = row & 4095; posidx = t; } else { const int r = row - MP; b = r >> 2; t = r & 3; posidx = SP + t; }
        const f32x4 partner = shfl_xor4(v, 32);
        if (c == 0 && d < 16) v = rope4(v, partner, rope, posidx, d);
        if (prompt) {
            if (br == 0) *(f32x4*)(out + o_cmp_p + (size_t)row * 512 + cc) = v;
            else if (br == 1) *(f32x4*)(out + o_slc_p + (size_t)row * 512 + cc) = v;
            else if (t >= SP - 512) *(f32x4*)(out + o_win_p + ((size_t)b * 512 + (t - (SP - 512))) * 512 + cc) = v;
            if (br >= 1) {
                if (c == 0) { bf16* K = br == 1 ? KS : KW; *(u32x2*)(K + ((size_t)(b * 4 + hh) * SP + t) * 64 + d) = pk4(v); }
                else { bf16* VT = br == 1 ? VTS : VTW; bf16* p = VT + ((size_t)(b * 4 + hh) * 64 + d) * SP + t; const u32x2 w = pk4(v);
                       p[0] = (bf16)(w.x & 0xffffu); p[SP] = (bf16)(w.x >> 16); p[2 * SP] = (bf16)(w.y & 0xffffu); p[3 * SP] = (bf16)(w.y >> 16); }
            }
        } else {
            if (br == 0) *(f32x4*)(out + o_cmp_s + (size_t)(b * 4 + t) * 512 + cc) = v;
            else if (br == 1) *(f32x4*)(out + o_slc_s + (size_t)(b * 4 + t) * 512 + cc) = v;
            else *(f32x4*)(out + o_win_s + ((size_t)b * 512 + 508 + t) * 512 + cc) = v;
        }
    } };
struct FInB {
    const float* rope; bf16 *Q, *QM; float* G;
    __device__ __forceinline__ void operator()(int row, int col, f32x4 v) const {
        const int posidx = row < MP ? (row & 4095) : SP + ((row - MP) & 3);
        const f32x4 partner = shfl_xor4(v, 32);
        if (col < AW) { const int d = col & 63; if (d < 16) v = rope4(v, partner, rope, posidx, d); *(u32x2*)(Q + (size_t)row * AW + col) = pk4(v); }
        else if (col < AW + MW) *(u32x2*)(QM + (size_t)row * MW + (col - AW)) = pk4(v);
        else if (col < AW + MW + 36) { f32x4 s; s[0] = sigmoid_f(v[0]); s[1] = sigmoid_f(v[1]); s[2] = sigmoid_f(v[2]); s[3] = sigmoid_f(v[3]); *(f32x4*)(G + (size_t)row * 36 + (col - AW - MW)) = s; }
    } };
struct FMemKV {
    float* out; bf16 *KM, *VTM;
    __device__ __forceinline__ void operator()(int row, int col, f32x4 v) const {
        const int l = col >> 9, cc = col & 511, c = cc >> 8, hh = (cc >> 6) & 3, d = cc & 63, b = row >> 8, m = row & 255;
        *(f32x4*)(out + ((size_t)l * 1024 + row) * 512 + cc) = v;
        if (c == 0) *(u32x2*)(KM + ((size_t)((l * 4 + b) * 4 + hh) * 256 + m) * 64 + d) = pk4(v);
        else { bf16* p = VTM + ((size_t)((l * 4 + b) * 4 + hh) * 64 + d) * 256 + m; const u32x2 w = pk4(v);
               p[0] = (bf16)(w.x & 0xffffu); p[256] = (bf16)(w.x >> 16); p[512] = (bf16)(w.y & 0xffffu); p[768] = (bf16)(w.y >> 16); }
    } };
constexpr int LDS_BYTES = 163840, CTRL_OFF = 159744, MISC_OFF = CTRL_OFF + 320, INPTR_OFF = CTRL_OFF + 1024;
constexpr size_t al256(size_t x) { return (x + 255) & ~(size_t)255; }
constexpr size_t WS_CTL = 0, CTL_BYTES = 1u << 20;
constexpr size_t WS_W_INA = CTL_BYTES, WS_W_OUTA = WS_W_INA + (size_t)2 * NIA * D * 2, WS_W_INB = WS_W_OUTA + (size_t)2 * D * D * 2, WS_W_OUTB = WS_W_INB + (size_t)2 * NIBP * D * 2,
                 WS_W_KV = WS_W_OUTB + (size_t)2 * D * D * 2, WS_W_UP = WS_W_KV + (size_t)NKV * D * 2, WS_W_DOWN = WS_W_UP + (size_t)4 * FF * D * 2, WS_W_MEM = WS_W_DOWN + (size_t)4 * FF * D * 2,
                 WS_W_PHI1T = WS_W_MEM + (size_t)2048 * D * 2, WS_W_PHI2T = WS_W_PHI1T + (size_t)2 * 128 * 2048 * 2, WS_PEB = WS_W_PHI2T + (size_t)2 * 64 * 128 * 2, WS_ROPE = WS_PEB + 1024,
                 WS_XRES = al256(WS_ROPE + (size_t)(SP + TS) * 16 * 4), WS_Z = WS_XRES + (size_t)MT * D * 4, WS_ZS = WS_Z + (size_t)MT * D * 4, WS_GT = WS_ZS + (size_t)8 * MS * D * 4,
                 WS_KVCS = al256(WS_GT + (size_t)MT * 36 * 4), WS_XB = WS_KVCS + (size_t)BS * 4 * 512 * 128 * 4, WS_U = WS_XB + (size_t)MT * D * 2, WS_VP = WS_U + (size_t)MT * AW * 2,
                 WS_QM = WS_VP + (size_t)MT * AW * 2, WS_QB = WS_QM + (size_t)MT * MW * 2, WS_CAT = WS_QB + (size_t)MT * AW * 2, WS_HB = WS_CAT + (size_t)MT * D * 2,
                 WS_KSLC = WS_HB + (size_t)MT * FF * 2, WS_VTSLC = WS_KSLC + (size_t)16 * SP * 64 * 2, WS_KWIN = WS_VTSLC + (size_t)16 * SP * 64 * 2, WS_VTWIN = WS_KWIN + (size_t)16 * SP * 64 * 2,
                 WS_KCMP = WS_VTWIN + (size_t)16 * SP * 64 * 2, WS_VTCMP = WS_KCMP + (size_t)16 * 256 * 64 * 2, WS_KMEM = WS_VTCMP + (size_t)16 * 256 * 64 * 2, WS_VTMEM = WS_KMEM + (size_t)64 * 256 * 64 * 2,
                 WS_END = WS_VTMEM + (size_t)64 * 256 * 64 * 2;
struct Frame {
    LAS unsigned char* lds;
    int tid, lane, wid, G, bid;
    unsigned char* ws; float* out;
    __device__ __forceinline__ const void* inp(int i) const { const LAS unsigned* p = (const LAS unsigned*)(lds + INPTR_OFF) + 2 * i;
        const unsigned lo = __builtin_amdgcn_readfirstlane(p[0]), hi = __builtin_amdgcn_readfirstlane(p[1]); return (const void*)(((unsigned long long)hi << 32) | lo); }
    __device__ __forceinline__ const float* x_prompt() const { return (const float*)inp(0); }
    __device__ __forceinline__ const float* x_sample() const { return (const float*)inp(1); }
    __device__ __forceinline__ const float* cache_cmp() const { return (const float*)inp(2); }
    __device__ __forceinline__ const float* cache_slc() const { return (const float*)inp(3); }
    __device__ __forceinline__ const float* cache_win() const { return (const float*)inp(4); }
    __device__ __forceinline__ const float* cache_mem() const { return (const float*)inp(5); }
    __device__ __forceinline__ const int* page_table() const { return (const int*)inp(6); }
    __device__ __forceinline__ const float* mem_prompt() const { return (const float*)inp(7); }
    __device__ __forceinline__ const float* w_in_a() const { return (const float*)inp(8); }
    __device__ __forceinline__ const float* ln_v_g() const { return (const float*)inp(9); }
    __device__ __forceinline__ const float* ln_v_b() const { return (const float*)inp(10); }
    __device__ __forceinline__ const float* w_spatial() const { return (const float*)inp(11); }
    __device__ __forceinline__ const float* b_spatial() const { return (const float*)inp(12); }
    __device__ __forceinline__ const float* w_out_a() const { return (const float*)inp(13); }
    __device__ __forceinline__ const float* w_in_b() const { return (const float*)inp(14); }
    __device__ __forceinline__ const float* w_out_b() const { return (const float*)inp(15); }
    __device__ __forceinline__ const float* w_kv() const { return (const float*)inp(16); }
    __device__ __forceinline__ const float* cmp_pe() const { return (const float*)inp(17); }
    __device__ __forceinline__ const float* w_phi1() const { return (const float*)inp(18); }
    __device__ __forceinline__ const float* w_phi2() const { return (const float*)inp(19); }
    __device__ __forceinline__ const float* w_mem_kv() const { return (const float*)inp(20); }
    __device__ __forceinline__ const float* ln1_g() const { return (const float*)inp(21); }
    __device__ __forceinline__ const float* ln1_b() const { return (const float*)inp(22); }
    __device__ __forceinline__ const float* ln2_g() const { return (const float*)inp(23); }
    __device__ __forceinline__ const float* ln2_b() const { return (const float*)inp(24); }
    __device__ __forceinline__ const float* w_up() const { return (const float*)inp(25); }
    __device__ __forceinline__ const float* w_down() const { return (const float*)inp(26); }
    __device__ __forceinline__ bf16* W_INA() const { return (bf16*)(ws + WS_W_INA); }
    __device__ __forceinline__ bf16* W_OUTA() const { return (bf16*)(ws + WS_W_OUTA); }
    __device__ __forceinline__ bf16* W_INB() const { return (bf16*)(ws + WS_W_INB); }
    __device__ __forceinline__ bf16* W_OUTB() const { return (bf16*)(ws + WS_W_OUTB); }
    __device__ __forceinline__ bf16* W_KV() const { return (bf16*)(ws + WS_W_KV); }
    __device__ __forceinline__ bf16* W_UP() const { return (bf16*)(ws + WS_W_UP); }
    __device__ __forceinline__ bf16* W_DOWN() const { return (bf16*)(ws + WS_W_DOWN); }
    __device__ __forceinline__ bf16* W_MEM() const { return (bf16*)(ws + WS_W_MEM); }
    __device__ __forceinline__ bf16* W_PHI1T() const { return (bf16*)(ws + WS_W_PHI1T); }
    __device__ __forceinline__ bf16* W_PHI2T() const { return (bf16*)(ws + WS_W_PHI2T); }
    __device__ __forceinline__ float* PEB() const { return (float*)(ws + WS_PEB); }
    __device__ __forceinline__ float* ROPE() const { return (float*)(ws + WS_ROPE); }
    __device__ __forceinline__ float* XRES() const { return (float*)(ws + WS_XRES); }
    __device__ __forceinline__ float* Z() const { return (float*)(ws + WS_Z); }
    __device__ __forceinline__ float* ZS() const { return (float*)(ws + WS_ZS); }
    __device__ __forceinline__ float* GT() const { return (float*)(ws + WS_GT); }
    __device__ __forceinline__ float* KVCS() const { return (float*)(ws + WS_KVCS); }
    __device__ __forceinline__ bf16* XB() const { return (bf16*)(ws + WS_XB); }
    __device__ __forceinline__ bf16* U() const { return (bf16*)(ws + WS_U); }
    __device__ __forceinline__ bf16* VP() const { return (bf16*)(ws + WS_VP); }
    __device__ __forceinline__ bf16* QM() const { return (bf16*)(ws + WS_QM); }
    __device__ __forceinline__ bf16* QB() const { return (bf16*)(ws + WS_QB); }
    __device__ __forceinline__ bf16* CAT() const { return (bf16*)(ws + WS_CAT); }
    __device__ __forceinline__ bf16* HB() const { return (bf16*)(ws + WS_HB); }
    __device__ __forceinline__ bf16* KSLC() const { return (bf16*)(ws + WS_KSLC); }
    __device__ __forceinline__ bf16* VTSLC() const { return (bf16*)(ws + WS_VTSLC); }
    __device__ __forceinline__ bf16* KWIN() const { return (bf16*)(ws + WS_KWIN); }
    __device__ __forceinline__ bf16* VTWIN() const { return (bf16*)(ws + WS_VTWIN); }
    __device__ __forceinline__ bf16* KCMP() const { return (bf16*)(ws + WS_KCMP); }
    __device__ __forceinline__ bf16* VTCMP() const { return (bf16*)(ws + WS_VTCMP); }
    __device__ __forceinline__ bf16* KMEM() const { return (bf16*)(ws + WS_KMEM); }
    __device__ __forceinline__ bf16* VTMEM() const { return (bf16*)(ws + WS_VTMEM); }
};
constexpr size_t O_Y_P = 0, O_Y_S = O_Y_P + (size_t)MP * D, O_CMP_P = O_Y_S + (size_t)MS * D, O_SLC_P = O_CMP_P + (size_t)MP * 512, O_WIN_P = O_SLC_P + (size_t)MP * 512,
                 O_MEM_P = O_WIN_P + (size_t)BP * 512 * 512, O_CMP_S = O_MEM_P + (size_t)4 * BP * 256 * 512, O_SLC_S = O_CMP_S + (size_t)MS * 512, O_WIN_S = O_SLC_S + (size_t)MS * 512,
                 O_GV_S = O_WIN_S + (size_t)BS * 512 * 512, O_END = O_GV_S + (size_t)2 * MS * AW;

template <class RM>
__device__ __forceinline__ void tr_item(const float* W, int K, int N, bf16* WT, const RM& rm, LAS unsigned* scr, int item, int lane) {
    const int nblk = (N + 63) / 64, kb = item / nblk, nb = item % nblk, k0 = 64 * kb, n0 = 64 * nb;
    const int kr = lane >> 4, nc = lane & 15, nn = n0 + 4 * nc;
    f32x4 ve[8], vo[8];
#pragma unroll
    for (int g = 0; g < 8; ++g) { const int k = k0 + 8 * g + 2 * kr;
        if (nn < N) { ve[g] = *(const f32x4*)(W + (size_t)k * N + nn); vo[g] = *(const f32x4*)(W + (size_t)(k + 1) * N + nn); }
        else { ve[g] = (f32x4){0.f, 0.f, 0.f, 0.f}; vo[g] = ve[g]; } }
#pragma unroll
    for (int g = 0; g < 8; ++g) { u32x4 p; p.x = pk2(ve[g][0], vo[g][0]); p.y = pk2(ve[g][1], vo[g][1]); p.z = pk2(ve[g][2], vo[g][2]); p.w = pk2(ve[g][3], vo[g][3]);
        *(LAS u32x4*)(scr + (4 * g + kr) * 68 + 4 * nc) = p; }
    LDS_WAIT(); asm volatile("" ::: "memory");
    const int n = n0 + lane;
    u32x4 o[8];
#pragma unroll
    for (int q = 0; q < 8; ++q) { o[q].x = scr[(4 * q + 0) * 68 + lane]; o[q].y = scr[(4 * q + 1) * 68 + lane]; o[q].z = scr[(4 * q + 2) * 68 + lane]; o[q].w = scr[(4 * q + 3) * 68 + lane]; }
    if (n < N) { bf16* dst = WT + (size_t)rm(n) * K + k0;
#pragma unroll
        for (int q = 0; q < 8; ++q) *(u32x4*)(dst + 8 * q) = o[q]; }
    LDS_WAIT(); asm volatile("" ::: "memory");
}
struct RMId { int off; __device__ __forceinline__ int operator()(int n) const { return off + n; } };
struct RMInB { __device__ __forceinline__ int operator()(int n) const { return n < AW ? n : (n < AW + 36 ? AW + MW + (n - AW) : AW + (n - AW - 36)); } };

__device__ __forceinline__ void p_prologue(Frame& F) {
    LAS unsigned* scr = (LAS unsigned*)(F.lds + F.wid * 16384);
    const int gw = F.bid * 8 + F.wid, NGW = F.G * 8, gt = F.bid * 512 + F.tid, NGT = F.G * 512;
    {
        constexpr int I_INA = (D / 64) * (NIA / 64), I_SQ = (D / 64) * (D / 64), I_INB = (D / 64) * ((NIB + 63) / 64), I_KV = (D / 64) * (NKV / 64), I_UP = (D / 64) * (FF / 64), I_DN = (FF / 64) * (D / 64), I_MEM = (D / 64) * (512 / 64);
        constexpr int NITEMS = 2 * I_INA + 2 * I_SQ + 2 * I_INB + 2 * I_SQ + I_KV + 4 * I_UP + 4 * I_DN + 4 * I_MEM;
        for (int it = gw; it < NITEMS; it += NGW) {
            int r = it;
            if (r < 2 * I_INA) { const int l = r / I_INA; tr_item(F.w_in_a() + (size_t)l * D * NIA, D, NIA, F.W_INA() + (size_t)l * NIA * D, RMId{0}, scr, r % I_INA, F.lane); continue; } r -= 2 * I_INA;
            if (r < 2 * I_SQ) { const int l = r / I_SQ; tr_item(F.w_out_a() + (size_t)l * D * D, D, D, F.W_OUTA() + (size_t)l * D * D, RMId{0}, scr, r % I_SQ, F.lane); continue; } r -= 2 * I_SQ;
            if (r < 2 * I_INB) { const int l = r / I_INB; tr_item(F.w_in_b() + (size_t)l * D * NIB, D, NIB, F.W_INB() + (size_t)l * NIBP * D, RMInB{}, scr, r % I_INB, F.lane); continue; } r -= 2 * I_INB;
            if (r < 2 * I_SQ) { const int l = r / I_SQ; tr_item(F.w_out_b() + (size_t)l * D * D, D, D, F.W_OUTB() + (size_t)l * D * D, RMId{0}, scr, r % I_SQ, F.lane); continue; } r -= 2 * I_SQ;
            if (r < I_KV) { tr_item(F.w_kv(), D, NKV, F.W_KV(), RMId{0}, scr, r, F.lane); continue; } r -= I_KV;
            if (r < 4 * I_UP) { const int l = r / I_UP; tr_item(F.w_up() + (size_t)l * D * FF, D, FF, F.W_UP() + (size_t)l * FF * D, RMId{0}, scr, r % I_UP, F.lane); continue; } r -= 4 * I_UP;
            if (r < 4 * I_DN) { const int l = r / I_DN; tr_item(F.w_down() + (size_t)l * FF * D, FF, D, F.W_DOWN() + (size_t)l * D * FF, RMId{0}, scr, r % I_DN, F.lane); continue; } r -= 4 * I_DN;
            { const int l = r / I_MEM; tr_item(F.w_mem_kv() + (size_t)l * D * 512, D, 512, F.W_MEM(), RMId{l * 512}, scr, r % I_MEM, F.lane); }
        }
    }
    for (int i = gt; i < 2 * (NIBP - NIB) * D / 8; i += NGT) { const int l = i / ((NIBP - NIB) * D / 8), r = i % ((NIBP - NIB) * D / 8);
        *(u32x4*)(F.W_INB() + (size_t)l * NIBP * D + (size_t)NIB * D + (size_t)r * 8) = (u32x4){0u, 0u, 0u, 0u}; }
    for (int row = gw; row < MT; row += NGW) {
        const float* src = row < MP ? F.x_prompt() + (size_t)row * D : F.x_sample() + (size_t)(row - MP) * D;
#pragma unroll
        for (int j = 0; j < 4; ++j) { const f32x4 v = *(const f32x4*)(src + 256 * j + 4 * F.lane);
            *(f32x4*)(F.XRES() + (size_t)row * D + 256 * j + 4 * F.lane) = v; *(u32x2*)(F.XB() + (size_t)row * D + 256 * j + 4 * F.lane) = pk4(v); }
    }
    for (int rr = gw; rr < BS * 508; rr += NGW) { const int b = rr / 508, r = rr % 508;
        const float* src = F.cache_win() + ((size_t)b * 512 + r + 4) * 512; float* dst = F.out + O_WIN_S + ((size_t)b * 512 + r) * 512;
#pragma unroll
        for (int j = 0; j < 2; ++j) *(f32x4*)(dst + 256 * j + 4 * F.lane) = *(const f32x4*)(src + 256 * j + 4 * F.lane); }
    for (int i = gt; i < (SP + TS) * 8; i += NGT) { const int pi = i >> 3, k = i & 7; const double pos = pi < SP ? (double)pi : (double)(PAST + pi - SP);
        double inv = 1.0; for (int j = 0; j < k; ++j) inv *= 0.19392274474868576;
        double rev = pos * inv * 0.15915494309189535; rev -= __builtin_floor(rev);
        F.ROPE()[(size_t)pi * 16 + k] = __builtin_amdgcn_cosf((float)rev); F.ROPE()[(size_t)pi * 16 + 8 + k] = __builtin_amdgcn_sinf((float)rev); }
    for (int i = gt; i < 2 * 128 * 2048; i += NGT) { const int c = i / (128 * 2048), e = (i / 2048) % 128, k = i % 2048, s = k >> 6, d = k & 63;
        const float v = F.w_phi1()[((size_t)(s * 2 + c) * 64 + d) * 128 + e]; F.W_PHI1T()[i] = (bf16)(pk2(v, 0.f) & 0xffffu); }
    for (int i = gt; i < 2 * 64 * 128; i += NGT) { const int c = i / (64 * 128), d = (i / 128) % 64, e = i % 128;
        const float v = F.w_phi2()[((size_t)c * 128 + e) * 64 + d]; F.W_PHI2T()[i] = (bf16)(pk2(v, 0.f) & 0xffffu); }
    for (int o = gw; o < 256; o += NGW) { const int c = o >> 7, e = o & 127; float a = 0.f;
        for (int k = F.lane; k < 2048; k += 64) { const int s = k >> 6, d = k & 63; a += F.cmp_pe()[(s * 2 + c) * 64 + d] * F.w_phi1()[((size_t)(s * 2 + c) * 64 + d) * 128 + e]; }
        a = wave_sum(a); if (F.lane == 0) F.PEB()[o] = a; }
    for (int i = gt; i < 16 * 64; i += NGT) { const int bg = i >> 6, d = i & 63; F.KCMP()[((size_t)bg * 256 + 255) * 64 + d] = 0; F.VTCMP()[((size_t)bg * 64 + d) * 256 + 255] = 0; }
}

__device__ __forceinline__ void ln_pass(Frame& F, const float* g, const float* bta, int nslab, float* outf_p, float* outf_s, bf16* outb, int row_end = MT) {
    const int gw = F.bid * 8 + F.wid, NGW = F.G * 8;
    for (int row = gw; row < row_end; row += NGW) {
        f32x4 v[4]; float s = 0.f;
        if (row < MP) {
#pragma unroll
            for (int j = 0; j < 4; ++j) v[j] = *(const f32x4*)(F.Z() + (size_t)row * D + 256 * j + 4 * F.lane);
        } else {
#pragma unroll
            for (int j = 0; j < 4; ++j) { v[j] = *(const f32x4*)(F.XRES() + (size_t)row * D + 256 * j + 4 * F.lane) * ALPHA;
                for (int ks = 0; ks < nslab; ++ks) v[j] += *(const f32x4*)(F.ZS() + ((size_t)ks * MS + (row - MP)) * D + 256 * j + 4 * F.lane); }
        }
#pragma unroll
        for (int j = 0; j < 4; ++j) s += (v[j][0] + v[j][1]) + (v[j][2] + v[j][3]);
        const float mean = wave_sum(s) * (1.f / D); float s2 = 0.f;
#pragma unroll
        for (int j = 0; j < 4; ++j) { v[j] = v[j] - mean; s2 += (v[j][0] * v[j][0] + v[j][1] * v[j][1]) + (v[j][2] * v[j][2] + v[j][3] * v[j][3]); }
        const float rstd = 1.f / sqrtf(wave_sum(s2) * (1.f / D) + LN_EPS);
        float* of = row < MP ? outf_p + (size_t)row * D : outf_s + (size_t)(row - MP) * D;
#pragma unroll
        for (int j = 0; j < 4; ++j) { const int c = 256 * j + 4 * F.lane; const f32x4 o = v[j] * rstd * *(const f32x4*)(g + c) + *(const f32x4*)(bta + c);
            *(f32x4*)(of + c) = o; if (outb) *(u32x2*)(outb + (size_t)row * D + c) = pk4(o); }
    }
}
template <int NH> struct Flash {
    f32x4 o[NH][4]; float m[NH], l[NH];
    __device__ __forceinline__ void init() {
#pragma unroll
        for (int r = 0; r < NH; ++r) { m[r] = -1e30f; l[r] = 0.f;
#pragma unroll
            for (int n = 0; n < 4; ++n) o[r][n] = (f32x4){0.f, 0.f, 0.f, 0.f}; } }
    __device__ __forceinline__ void finish() {
#pragma unroll
        for (int r = 0; r < NH; ++r) { float lt = l[r]; lt += __shfl_xor(lt, 16); lt += __shfl_xor(lt, 32); const float inv = lt > 0.f ? 1.0f / lt : 0.f;
#pragma unroll
            for (int n = 0; n < 4; ++n) o[r][n] = o[r][n] * inv; } }
};
constexpr int TILE_K_BYTES = 64 * 144, TILE_BYTES = TILE_K_BYTES + 64 * 136, TILE_OFF = 98304;
struct TileStage { u32x4 kr, vr; };
__device__ __forceinline__ void tile_issue(TileStage& s, const bf16* K, const bf16* Vt, int ldv, int key0, int tid) {
    const int row = tid >> 3, ch = tid & 7;
    s.kr = *(const u32x4*)(K + (size_t)(key0 + row) * 64 + ch * 8);
    s.vr = *(const u32x4*)(Vt + (size_t)row * ldv + key0 + ch * 8);
}
__device__ __forceinline__ void tile_write(const TileStage& s, LAS unsigned char* buf, int tid) {
    const int row = tid >> 3, ch = tid & 7;
    *(LAS u32x4*)(buf + row * 144 + ch * 16) = s.kr;
    LAS u32x2* vp = (LAS u32x2*)(buf + TILE_K_BYTES + row * 136 + ch * 16); vp[0] = (u32x2){s.vr.x, s.vr.y}; vp[1] = (u32x2){s.vr.z, s.vr.w};
}
struct KVFrag { bf16x8 ka0, ka1, kb0, kb1, vf[4]; };
__device__ __forceinline__ void load_kv_lds(KVFrag& f, const LAS unsigned char* buf, int h, int qi, int g4) {
    const LAS unsigned char* kp = buf + (32 * h + qi) * 144 + 16 * g4;
    f.ka0 = *(const LAS bf16x8*)(kp); f.ka1 = *(const LAS bf16x8*)(kp + 64); f.kb0 = *(const LAS bf16x8*)(kp + 16 * 144); f.kb1 = *(const LAS bf16x8*)(kp + 16 * 144 + 64);
#pragma unroll
    for (int n = 0; n < 4; ++n) { const LAS unsigned char* vp = buf + TILE_K_BYTES + (16 * n + qi) * 136 + 64 * h + 8 * g4; const u32x2 lo = *(const LAS u32x2*)vp, hi = *(const LAS u32x2*)(vp + 32);
        f.vf[n] = __builtin_bit_cast(bf16x8, (u32x4){lo.x, lo.y, hi.x, hi.y}); }
}
template <int NH, class Mask>
__device__ __forceinline__ void flash_step(Flash<NH>& st, const bf16x8 (&qf)[NH][2], const LAS unsigned char* buf, int h, int key0, int qi, int g4, const Mask& mask) {
    KVFrag f; load_kv_lds(f, buf, h, qi, g4);
    bool va[4], vb[4];
#pragma unroll
    for (int j = 0; j < 4; ++j) { va[j] = mask(key0 + 4 * g4 + j); vb[j] = mask(key0 + 16 + 4 * g4 + j); }
#pragma unroll
    for (int r = 0; r < NH; ++r) {
        f32x4 sa = MFMA16(f.ka0, qf[r][0], ((f32x4){0.f, 0.f, 0.f, 0.f})); sa = MFMA16(f.ka1, qf[r][1], sa);
        f32x4 sb = MFMA16(f.kb0, qf[r][0], ((f32x4){0.f, 0.f, 0.f, 0.f})); sb = MFMA16(f.kb1, qf[r][1], sb);
        float mx = NEG_INF;
#pragma unroll
        for (int j = 0; j < 4; ++j) { sa[j] = va[j] ? sa[j] * QSC : NEG_INF; sb[j] = vb[j] ? sb[j] * QSC : NEG_INF; mx = fmaxf(mx, fmaxf(sa[j], sb[j])); }
        if (__any(mx - st.m[r] > 8.0f)) {
            mx = fmaxf(mx, __shfl_xor(mx, 16)); mx = fmaxf(mx, __shfl_xor(mx, 32));
            const float mn = fmaxf(st.m[r], mx), alpha = ex2(st.m[r] - mn); st.m[r] = mn; st.l[r] *= alpha;
#pragma unroll
            for (int n = 0; n < 4; ++n) st.o[r][n] = st.o[r][n] * alpha;
        }
        const float mr = st.m[r]; float ps = 0.f;
#pragma unroll
        for (int j = 0; j < 4; ++j) { sa[j] = ex2(sa[j] - mr); sb[j] = ex2(sb[j] - mr); ps += sa[j] + sb[j]; }
        st.l[r] += ps;
        const bf16x8 pf = pk8(sa, sb);
#pragma unroll
        for (int n = 0; n < 4; ++n) st.o[r][n] = MFMA16(f.vf[n], pf, st.o[r][n]);
    }
}
template <int NH> __device__ __forceinline__ void load_q(bf16x8 (&qf)[NH][2], const bf16* Q, int ldq, int row, int g4) {
#pragma unroll
    for (int r = 0; r < NH; ++r) { const bf16* p = Q + (size_t)row * ldq + r * 64 + 8 * g4; qf[r][0] = *(const bf16x8*)p; qf[r][1] = *(const bf16x8*)(p + 32); }
}
template <class Next, class Compute>
__device__ __forceinline__ void tile_loop(Frame& F, const bf16* K, const bf16* Vt, int ldv, int first, const Next& next  , const Compute& compute) {
    LAS unsigned char* tb = F.lds + TILE_OFF;
    if (first < 0) return;
    TileStage s; tile_issue(s, K, Vt, ldv, first, F.tid); tile_write(s, tb, F.tid);
    __syncthreads();
    int cur = first, par = 0;
    while (cur >= 0) {
        const int nx = next(cur);
        if (nx >= 0) tile_issue(s, K, Vt, ldv, nx, F.tid);
        compute(tb + par * TILE_BYTES, cur);
        if (nx >= 0) tile_write(s, tb + (par ^ 1) * TILE_BYTES, F.tid);
        __syncthreads();
        cur = nx; par ^= 1;
    }
}

__device__ __forceinline__ void mem_prompt_unit(Frame& F, int l, int unit) {
    const int qt = unit & 31, hh = (unit >> 5) & 3, b = unit >> 7, qi = F.lane & 15, g4 = F.lane >> 4;
    const int row = b * SP + qt * 128 + F.wid * 16 + qi;
    const bf16* K = F.KMEM() + (size_t)((l * 4 + b) * 4 + hh) * 256 * 64; const bf16* Vt = F.VTMEM() + (size_t)((l * 4 + b) * 4 + hh) * 64 * 256;
    bf16x8 qf[1][2]; load_q<1>(qf, F.QM() + hh * 64, MW, row, g4);
    Flash<1> st; st.init();
    tile_loop(F, K, Vt, 256, 0, [](int k0) { return k0 + 64 < 256 ? k0 + 64 : -1; },
        [&](const LAS unsigned char* buf, int k0) {
#pragma unroll
            for (int h = 0; h < 2; ++h) flash_step<1>(st, qf, buf, h, k0 + 32 * h, qi, g4, [](int) { return true; }); });
    st.finish();
#pragma unroll
    for (int n = 0; n < 4; ++n) *(u32x2*)(F.CAT() + (size_t)row * D + AW + hh * 64 + 16 * n + 4 * g4) = pk4(st.o[0][n]);
}

__device__ __forceinline__ void spatial_unit(Frame& F, int l, int unit) {
    const int g = unit & 3, chunk = unit >> 2;
    const bool samp = chunk >= 128; const int row0 = samp ? MP + 4 * (chunk - 128) : chunk * 128, nrows = samp ? 4 : 128;
    LAS float* stat = (LAS float*)F.lds;
    LAS bf16* vT = (LAS bf16*)(F.lds + 1024);
    for (int r = F.wid * 16; r < F.wid * 16 + 16; ++r) {
        if (r < nrows) {
            const bf16* vp = F.VP() + (size_t)(row0 + r) * AW + 12 * F.lane; float x[12];
#pragma unroll
            for (int j = 0; j < 3; ++j) { const u32x2 w = *(const u32x2*)(vp + 4 * j); x[4 * j] = bf2f((bf16)(w.x & 0xffffu)); x[4 * j + 1] = bf2f((bf16)(w.x >> 16)); x[4 * j + 2] = bf2f((bf16)(w.y & 0xffffu)); x[4 * j + 3] = bf2f((bf16)(w.y >> 16)); }
            float s = 0.f;
#pragma unroll
            for (int j = 0; j < 12; ++j) s += x[j];
            const float mean = wave_sum(s) * (1.f / AW); float s2 = 0.f;
#pragma unroll
            for (int j = 0; j < 12; ++j) { const float dd = x[j] - mean; s2 += dd * dd; }
            const float rstd = 1.f / sqrtf(wave_sum(s2) * (1.f / AW) + LN_EPS);
            if (F.lane == 0) { stat[2 * r] = mean; stat[2 * r + 1] = rstd; }
        }
    }
    __syncthreads();
    const float* gam = F.ln_v_g() + l * AW + g * 192; const float* bet = F.ln_v_b() + l * AW + g * 192;
    for (int idx = F.tid; idx < 128 * 48; idx += 512) {
        const int r = idx / 48, cg = idx % 48;
        f32x4 v = {0.f, 0.f, 0.f, 0.f};
        if (r < nrows) {
            const u32x2 w = *(const u32x2*)(F.VP() + (size_t)(row0 + r) * AW + g * 192 + 4 * cg);
            const float mean = stat[2 * r], rstd = stat[2 * r + 1];
            const f32x4 x = {bf2f((bf16)(w.x & 0xffffu)), bf2f((bf16)(w.x >> 16)), bf2f((bf16)(w.y & 0xffffu)), bf2f((bf16)(w.y >> 16))};
            v = (x - mean) * rstd * *(const f32x4*)(gam + 4 * cg) + *(const f32x4*)(bet + 4 * cg);
            if (samp) *(f32x4*)(F.out + O_GV_S + ((size_t)l * MS + (row0 - MP) + r) * AW + g * 192 + 4 * cg) = v;
        }
        const u32x2 pv = pk4(v);
        vT[(4 * cg + 0) * 136 + r] = (bf16)(pv.x & 0xffffu); vT[(4 * cg + 1) * 136 + r] = (bf16)(pv.x >> 16); vT[(4 * cg + 2) * 136 + r] = (bf16)(pv.y & 0xffffu); vT[(4 * cg + 3) * 136 + r] = (bf16)(pv.y >> 16);
    }
    __syncthreads();
    if (F.wid * 16 < nrows) {
        const int fr = F.lane & 15, fq = F.lane >> 4, t = F.wid * 16 + fr;
        const float* Wg = F.w_spatial() + ((size_t)(l * 4 + g) * 128 + t) * 128;
        f32x4 acc[12];
#pragma unroll
        for (int n = 0; n < 12; ++n) acc[n] = (f32x4){0.f, 0.f, 0.f, 0.f};
        for (int ks = 0; ks <= (F.wid >> 1); ++ks) {
            const int s0 = 32 * ks + 8 * fq;
            f32x4 w0 = *(const f32x4*)(Wg + s0), w1 = *(const f32x4*)(Wg + s0 + 4);
#pragma unroll
            for (int j = 0; j < 4; ++j) { if (s0 + j > t) w0[j] = 0.f; if (s0 + 4 + j > t) w1[j] = 0.f; }
            const bf16x8 wf = pk8(w0, w1);
#pragma unroll
            for (int n = 0; n < 12; ++n) { const bf16x8 vfrag = *(const LAS bf16x8*)(vT + (16 * n + fr) * 136 + s0); acc[n] = MFMA16(vfrag, wf, acc[n]); }
        }
        if (t < nrows) {
            const float bs = F.b_spatial()[(l * 4 + g) * 128 + t];
#pragma unroll
            for (int n = 0; n < 12; ++n) { const int c = g * 192 + 16 * n + 4 * fq; const u32x2 uw = *(const u32x2*)(F.U() + (size_t)(row0 + t) * AW + c);
                f32x4 o; o[0] = (acc[n][0] + bs) * bf2f((bf16)(uw.x & 0xffffu)); o[1] = (acc[n][1] + bs) * bf2f((bf16)(uw.x >> 16)); o[2] = (acc[n][2] + bs) * bf2f((bf16)(uw.y & 0xffffu)); o[3] = (acc[n][3] + bs) * bf2f((bf16)(uw.y >> 16));
                *(u32x2*)(F.CAT() + (size_t)(row0 + t) * D + c) = pk4(o); }
        }
    }
    __syncthreads();
}
#define NSA_LATE(x) asm volatile("" : "+v"(x))
__device__ __forceinline__ void nsa_prompt_unit(Frame& F, int bg, int qt) {
    const int b = bg >> 2, g = bg & 3, qi = F.lane & 15, g4 = F.lane >> 4;
    const int t0b = qt * 128, t0 = t0b + F.wid * 16, t = t0 + qi, row = b * SP + t;
    bf16x8 qf[3][2]; load_q<3>(qf, F.QB() + g * 192, AW, row, g4);
    LAS float* park = (LAS float*)F.lds + F.tid;
    LAS unsigned char* tb = F.lds + TILE_OFF;
    unsigned mlo = 0u, mhi = 0u;
    {
        const bf16* Kc = F.KCMP() + (size_t)bg * 256 * 64; const bf16* Vc = F.VTCMP() + (size_t)bg * 64 * 256;
        const int nvq = t >= 31 ? ((t - 31) >> 4) + 1 : 0;
        const int nvmax = t0 + 15 >= 31 ? ((t0 + 15 - 31) >> 4) + 1 : 0;
        const int nvblk = 8 * qt + 7;
        const int ntile = (nvblk >> 6) + 1 < 4 ? (nvblk >> 6) + 1 : 4;
        float m[3], l[3];
#pragma unroll
        for (int r = 0; r < 3; ++r) { m[r] = -1e30f; l[r] = 0.f; }
        TileStage s;
        tile_issue(s, Kc, Vc, 256, 0, F.tid); tile_write(s, tb, F.tid); __syncthreads();
#pragma unroll
        for (int i = 0; i < 4; ++i) {
            if (i < ntile) {
                if (i + 1 < ntile) tile_issue(s, Kc, Vc, 256, 64 * (i + 1), F.tid);
                const LAS unsigned char* buf = tb + (i & 1) * TILE_BYTES;
#pragma unroll
                for (int h = 0; h < 2; ++h) {
                    const int key0 = 64 * i + 32 * h;
                    if (key0 < nvmax) {
                        const LAS unsigned char* kp = buf + (32 * h + qi) * 144 + 16 * g4;
                        const bf16x8 ka0 = *(const LAS bf16x8*)(kp), ka1 = *(const LAS bf16x8*)(kp + 64), kb0 = *(const LAS bf16x8*)(kp + 16 * 144), kb1 = *(const LAS bf16x8*)(kp + 16 * 144 + 64);
#pragma unroll
                        for (int r = 0; r < 3; ++r) {
                            f32x4 sa = MFMA16(ka0, qf[r][0], ((f32x4){0.f, 0.f, 0.f, 0.f})); sa = MFMA16(ka1, qf[r][1], sa);
                            f32x4 sb = MFMA16(kb0, qf[r][0], ((f32x4){0.f, 0.f, 0.f, 0.f})); sb = MFMA16(kb1, qf[r][1], sb);
                            float mx = NEG_INF;
#pragma unroll
                            for (int j = 0; j < 4; ++j) { sa[j] = (key0 + 4 * g4 + j < nvq) ? sa[j] * QSC : NEG_INF; sb[j] = (key0 + 16 + 4 * g4 + j < nvq) ? sb[j] * QSC : NEG_INF; mx = fmaxf(mx, fmaxf(sa[j], sb[j])); }
                            mx = fmaxf(mx, __shfl_xor(mx, 16)); mx = fmaxf(mx, __shfl_xor(mx, 32));
                            const float mn = fmaxf(m[r], mx); float ps = 0.f;
#pragma unroll
                            for (int j = 0; j < 4; ++j) ps += ex2(sa[j] - mn) + ex2(sb[j] - mn);
                            l[r] = l[r] * ex2(m[r] - mn) + ps; m[r] = mn;
                        }
                    }
                }
                if (i + 1 < ntile) tile_write(s, tb + ((i + 1) & 1) * TILE_BYTES, F.tid);
                __syncthreads();
            }
        }
        float invl[3];
#pragma unroll
        for (int r = 0; r < 3; ++r) { float lt = l[r]; lt += __shfl_xor(lt, 16); lt += __shfl_xor(lt, 32); invl[r] = lt > 0.f ? 1.0f / lt : 0.f; }
        f32x4 oc[3][4];
#pragma unroll
        for (int r = 0; r < 3; ++r)
#pragma unroll
            for (int n = 0; n < 4; ++n) oc[r][n] = (f32x4){0.f, 0.f, 0.f, 0.f};
        float imp[16];
#pragma unroll
        for (int k = 0; k < 16; ++k) imp[k] = 0.f;
        float prev_c3 = 0.f;
        const int src = (F.lane + 48) & 63;
        tile_issue(s, Kc, Vc, 256, 0, F.tid); tile_write(s, tb, F.tid); __syncthreads();
#pragma unroll
        for (int i = 0; i < 4; ++i) {
            if (i < ntile) {
                if (i + 1 < ntile) tile_issue(s, Kc, Vc, 256, 64 * (i + 1), F.tid);
                const LAS unsigned char* buf = tb + (i & 1) * TILE_BYTES;
#pragma unroll
                for (int h = 0; h < 2; ++h) {
                    const int kp_ = 2 * i + h, key0 = 32 * kp_;
                    if (key0 <= nvmax && nvmax > 0) {
                        KVFrag f; load_kv_lds(f, buf, h, qi, g4);
                        float own_a = 0.f, own_b = 0.f, c3a = 0.f, c3b = 0.f;
#pragma unroll
                        for (int r = 0; r < 3; ++r) {
                            f32x4 sa = MFMA16(f.ka0, qf[r][0], ((f32x4){0.f, 0.f, 0.f, 0.f})); sa = MFMA16(f.ka1, qf[r][1], sa);
                            f32x4 sb = MFMA16(f.kb0, qf[r][0], ((f32x4){0.f, 0.f, 0.f, 0.f})); sb = MFMA16(f.kb1, qf[r][1], sb);
#pragma unroll
                            for (int j = 0; j < 4; ++j) {
                                sa[j] = (key0 + 4 * g4 + j < nvq) ? ex2(sa[j] * QSC - m[r]) * invl[r] : 0.f;
                                sb[j] = (key0 + 16 + 4 * g4 + j < nvq) ? ex2(sb[j] * QSC - m[r]) * invl[r] : 0.f;
                                own_a += sa[j]; own_b += sb[j]; }
                            c3a += sa[3]; c3b += sb[3];
                            const bf16x8 pf = pk8(sa, sb);
#pragma unroll
                            for (int n = 0; n < 4; ++n) oc[r][n] = MFMA16(f.vf[n], pf, oc[r][n]);
                        }
                        const float send_a = (g4 == 3) ? prev_c3 : c3a; imp[2 * kp_] = own_a + __shfl(send_a, src);
                        const float send_b = (g4 == 3) ? c3a : c3b;     imp[2 * kp_ + 1] = own_b + __shfl(send_b, src);
                        prev_c3 = c3b;
                    }
                }
                if (i + 1 < ntile) tile_write(s, tb + ((i + 1) & 1) * TILE_BYTES, F.tid);
                __syncthreads();
            }
        }
        float gcmp[3]; { int rw = row; NSA_LATE(rw);
#pragma unroll
            for (int r = 0; r < 3; ++r) gcmp[r] = F.GT()[(size_t)rw * 36 + (3 * g + r) * 3 + 0]; }
#pragma unroll
        for (int r = 0; r < 3; ++r)
#pragma unroll
            for (int n = 0; n < 4; ++n)
#pragma unroll
                for (int j = 0; j < 4; ++j) park[(r * 16 + n * 4 + j) * 512] = oc[r][n][j] * gcmp[r];
        const int cur = t >> 6;
        float sc[16]; bool causal[16];
#pragma unroll
        for (int k = 0; k < 16; ++k) { const int jb = 4 * k + g4; causal[k] = jb <= cur; const bool forced = (jb == 0) | (jb == cur) | (jb + 1 == cur);
            sc[k] = causal[k] ? imp[k] + (forced ? 1e4f : 0.f) : -1e30f; }
        bool sel[16];
        if (t0 + 15 >= 16 * 64) {
            int rank[16];
#pragma unroll
            for (int k = 0; k < 16; ++k) rank[k] = 0;
#pragma unroll 1
            for (int gs = 0; gs < 4; ++gs) {
                const bool lt = gs < g4;
#pragma unroll
                for (int ks = 0; ks < 16; ++ks) {
                    const float v = __shfl(sc[ks], qi + 16 * gs);
#pragma unroll
                    for (int k = 0; k < 16; ++k) {
                        if (ks < k) rank[k] += (v >= sc[k]) ? 1 : 0;
                        else if (ks > k) rank[k] += (v > sc[k]) ? 1 : 0;
                        else rank[k] += ((v > sc[k]) | ((v == sc[k]) & lt)) ? 1 : 0;
                    }
                }
            }
#pragma unroll
            for (int k = 0; k < 16; ++k) sel[k] = causal[k] & (rank[k] < 16);
        } else {
#pragma unroll
            for (int k = 0; k < 16; ++k) sel[k] = causal[k];
        }
#pragma unroll
        for (int k = 0; k < 8; ++k) { mlo |= (sel[k] ? 1u : 0u) << (4 * k + g4); mhi |= (sel[k + 8] ? 1u : 0u) << (4 * k + g4); }
        mlo |= __shfl_xor(mlo, 16); mlo |= __shfl_xor(mlo, 32); mhi |= __shfl_xor(mhi, 16); mhi |= __shfl_xor(mhi, 32);
    }
    {
        unsigned wlo = mlo, whi = mhi;
#pragma unroll
        for (int o = 1; o < 16; o <<= 1) { wlo |= __shfl_xor(wlo, o); whi |= __shfl_xor(whi, o); }
        LAS unsigned* um = (LAS unsigned*)(F.lds + CTRL_OFF + 2048);
        if (F.lane == 0) { um[2 * F.wid] = wlo; um[2 * F.wid + 1] = whi; }
        __syncthreads();
        unsigned blo = 0u, bhi = 0u;
#pragma unroll
        for (int w = 0; w < 8; ++w) { blo |= um[2 * w]; bhi |= um[2 * w + 1]; }
        const unsigned long long bmask = ((unsigned long long)__builtin_amdgcn_readfirstlane(bhi) << 32) | (unsigned long long)__builtin_amdgcn_readfirstlane(blo);
        int bgl = bg; asm volatile("" : "+s"(bgl));
        const bf16* Ks = F.KSLC() + (size_t)bgl * SP * 64; const bf16* Vs = F.VTSLC() + (size_t)bgl * 64 * SP;
        Flash<3> st; st.init();
        tile_loop(F, Ks, Vs, SP, bmask ? 64 * (int)__builtin_ctzll(bmask) : -1,
            [&](int k0) { const int jb = k0 >> 6; const unsigned long long rem = jb >= 63 ? 0ull : (bmask >> (jb + 1)); return rem ? 64 * (jb + 1 + (int)__builtin_ctzll(rem)) : -1; },
            [&](const LAS unsigned char* buf, int k0) {
                const int jb = k0 >> 6;
                const bool mine = ((jb < 32 ? (mlo >> jb) : (mhi >> (jb - 32))) & 1u) != 0u;
                if (__any(mine)) {
#pragma unroll
                    for (int h = 0; h < 2; ++h) { const int key0 = k0 + 32 * h;
                        if (key0 <= t0 + 15) flash_step<3>(st, qf, buf, h, key0, qi, g4, [&](int key) { return mine && key <= t; }); }
                } });
        st.finish();
        float gsel[3]; { int rw = row; NSA_LATE(rw);
#pragma unroll
            for (int r = 0; r < 3; ++r) gsel[r] = F.GT()[(size_t)rw * 36 + (3 * g + r) * 3 + 1]; }
#pragma unroll
        for (int r = 0; r < 3; ++r)
#pragma unroll
            for (int n = 0; n < 4; ++n)
#pragma unroll
                for (int j = 0; j < 4; ++j) park[(r * 16 + n * 4 + j) * 512] += st.o[r][n][j] * gsel[r];
    }
    {
        int bgl = bg; asm volatile("" : "+s"(bgl));
        const bf16* Kw = F.KWIN() + (size_t)bgl * SP * 64; const bf16* Vw = F.VTWIN() + (size_t)bgl * 64 * SP;
        Flash<3> st; st.init();
        const int kfirst = (t0b > 511 ? t0b - 511 : 0) & ~63, klast = t0b + 64;
        tile_loop(F, Kw, Vw, SP, kfirst, [&](int k0) { return k0 + 64 <= klast ? k0 + 64 : -1; },
            [&](const LAS unsigned char* buf, int k0) {
#pragma unroll
                for (int h = 0; h < 2; ++h) { const int key0 = k0 + 32 * h;
                    if (key0 <= t0 + 15 && key0 + 31 + 512 > t0) flash_step<3>(st, qf, buf, h, key0, qi, g4, [&](int key) { return key <= t && key + 512 > t; }); } });
        st.finish();
        int rw = row, g4w = g4; NSA_LATE(rw); NSA_LATE(g4w);
        float gwin[3];
#pragma unroll
        for (int r = 0; r < 3; ++r) gwin[r] = F.GT()[(size_t)rw * 36 + (3 * g + r) * 3 + 2];
#pragma unroll
        for (int r = 0; r < 3; ++r)
#pragma unroll
            for (int n = 0; n < 4; ++n) { f32x4 o;
#pragma unroll
                for (int j = 0; j < 4; ++j) o[j] = park[(r * 16 + n * 4 + j) * 512] + st.o[r][n][j] * gwin[r];
                *(u32x2*)(F.CAT() + (size_t)rw * D + (3 * g + r) * 64 + 16 * n + 4 * g4w) = pk4(o); }
    }
    __syncthreads();
}
template <int NP> struct VState { float m[NP], l[NP], o[NP];
    __device__ __forceinline__ void init() {
#pragma unroll
        for (int p = 0; p < NP; ++p) { m[p] = -1e30f; l[p] = 0.f; o[p] = 0.f; } } };
template <int NP>
__device__ __forceinline__ void valu_scores(float (&x)[NP], const LAS float* qs, const float* kptr, bool valid) {
    f32x4 kr[16];
#pragma unroll
    for (int i = 0; i < 16; ++i) kr[i] = valid ? *(const f32x4*)(kptr + 4 * i) : (f32x4){0.f, 0.f, 0.f, 0.f};
    float a[NP];
#pragma unroll
    for (int p = 0; p < NP; ++p) a[p] = 0.f;
#pragma unroll
    for (int i = 0; i < 16; ++i) {
#pragma unroll
        for (int p = 0; p < NP; ++p) { const f32x4 q = *(const LAS f32x4*)(qs + p * 64 + 4 * i); a[p] += (kr[i][0] * q[0] + kr[i][1] * q[1]) + (kr[i][2] * q[2] + kr[i][3] * q[3]); }
        asm volatile("" ::: "memory");
    }
#pragma unroll
    for (int p = 0; p < NP; ++p) x[p] = valid ? a[p] : NEG_INF;
}
template <int NP>
__device__ __forceinline__ void valu_pv(float (&o)[NP], const float (&pr)[NP], const float* vbase, int vstride, int nk, int lane) {
#pragma unroll
    for (int k0 = 0; k0 < 64; k0 += 16) {
        if (k0 < nk) {
            float v[16];
#pragma unroll
            for (int k = 0; k < 16; ++k) v[k] = (k0 + k < nk) ? vbase[(size_t)(k0 + k) * vstride + lane] : 0.f;
#pragma unroll
            for (int k = 0; k < 16; ++k)
#pragma unroll
                for (int p = 0; p < NP; ++p) o[p] += __builtin_bit_cast(float, __builtin_amdgcn_readlane(__builtin_bit_cast(int, pr[p]), k0 + k)) * v[k];
            asm volatile("" ::: "memory");
        }
    }
}
template <int NP>
__device__ __forceinline__ void valu_block(VState<NP>& st, const LAS float* qs, const float* kptr, bool valid, const float* vbase, int vstride, int nk, int lane) {
    float x[NP], pr[NP]; valu_scores<NP>(x, qs, kptr, valid);
#pragma unroll
    for (int p = 0; p < NP; ++p) { const float mx = wave_max(x[p]), mn = fmaxf(st.m[p], mx), alpha = ex2(st.m[p] - mn); st.m[p] = mn;
        pr[p] = ex2(x[p] - mn); st.l[p] = st.l[p] * alpha + wave_sum(pr[p]); st.o[p] *= alpha; }
    valu_pv<NP>(st.o, pr, vbase, vstride, nk, lane);
}
template <int NP>
__device__ __forceinline__ float valu_combine(const VState<NP>& st, LAS float* scr, int wid, int lane) {
    LAS float* wm = scr; LAS float* wl = scr + 8 * NP; LAS float* wo = scr + 16 * NP;
#pragma unroll
    for (int p = 0; p < NP; ++p) { if (lane == 0) { wm[wid * NP + p] = st.m[p]; wl[wid * NP + p] = st.l[p]; } wo[(wid * NP + p) * 64 + lane] = st.o[p]; }
    __syncthreads();
    float res = 0.f;
    if (wid < NP) { float M = -1e30f;
#pragma unroll
        for (int w = 0; w < 8; ++w) M = fmaxf(M, wm[w * NP + wid]);
        float L = 0.f, O = 0.f;
#pragma unroll
        for (int w = 0; w < 8; ++w) { const float e = ex2(wm[w * NP + wid] - M); L += wl[w * NP + wid] * e; O += wo[(w * NP + wid) * 64 + lane] * e; }
        res = L > 0.f ? O / L : 0.f; }
    __syncthreads();
    return res;
}

__device__ __forceinline__ void mem_sample_task(Frame& F, int l, int task) {
    const int hh = task & 3, b = task >> 2;
    LAS float* qs = (LAS float*)F.lds; LAS float* scr = qs + 4 * 64;
    if (F.tid < 256) { const int tt = F.tid >> 6, d = F.tid & 63; qs[F.tid] = bf2f(F.QM()[(size_t)(MP + b * 4 + tt) * MW + hh * 64 + d]) * QSC; }
    __syncthreads();
    VState<4> st; st.init();
    if (F.wid < 4) {
        const float* base = F.cache_mem() + (((size_t)(l * BS + b) * 256 + 64 * F.wid) * 2) * 256 + hh * 64;
        valu_block<4>(st, qs, base + (size_t)F.lane * 512, true, base + 256, 512, 64, F.lane);
    }
    const float o = valu_combine<4>(st, scr, F.wid, F.lane);
    if (F.wid < 4) F.CAT()[(size_t)(MP + b * 4 + F.wid) * D + AW + hh * 64 + F.lane] = (bf16)(pk2(o, 0.f) & 0xffffu);
}

__device__ __forceinline__ void nsa_sample_task(Frame& F, int task) {
    const int tt = task & 3, g = (task >> 2) & 3, b = task >> 4, row = MP + b * 4 + tt;
    LAS float* qs = (LAS float*)F.lds;
    LAS float* scr = qs + 192;
    LAS float* red = scr + 1600;
    LAS float* P3 = red + 64;
    LAS float* scl = P3 + 520;
    LAS int* slist = (LAS int*)(scl + 136);
    if (F.tid < 192) qs[F.tid] = bf2f(F.QB()[(size_t)row * AW + g * 192 + F.tid]) * QSC;
    if (F.tid < 16) slist[F.tid] = 0;
    __syncthreads();
    float gate0 = 0.f, gate1 = 0.f, gate2 = 0.f;
    if (F.wid < 3) { const float* gp = F.GT() + (size_t)row * 36 + (3 * g + F.wid) * 3; gate0 = gp[0]; gate1 = gp[1]; gate2 = gp[2]; }
    float otot = 0.f;
    {
        const int n = 64 * F.wid + F.lane; const bool valid = n < 511;
        const float* kvb = F.KVCS() + (size_t)(b * 4 + g) * 512 * 128;
        float x[3]; valu_scores<3>(x, qs, kvb + (size_t)n * 128, valid);
#pragma unroll
        for (int p = 0; p < 3; ++p) { const float mx = wave_max(x[p]); if (F.lane == 0) red[F.wid * 3 + p] = mx; }
        __syncthreads();
        float pr[3], psum = 0.f;
#pragma unroll
        for (int p = 0; p < 3; ++p) { float M = -1e30f;
#pragma unroll
            for (int w = 0; w < 8; ++w) M = fmaxf(M, red[w * 3 + p]);
            pr[p] = ex2(x[p] - M); }
        __syncthreads();
#pragma unroll
        for (int p = 0; p < 3; ++p) { const float s = wave_sum(pr[p]); if (F.lane == 0) red[F.wid * 3 + p] = s; }
        __syncthreads();
#pragma unroll
        for (int p = 0; p < 3; ++p) { float L = 0.f;
#pragma unroll
            for (int w = 0; w < 8; ++w) L += red[w * 3 + p];
            pr[p] = pr[p] / L; psum += pr[p]; }
        P3[n] = psum;
        if (F.tid < 4) P3[512 + F.tid] = 0.f;
        float o[3] = {0.f, 0.f, 0.f};
        valu_pv<3>(o, pr, kvb + (size_t)(64 * F.wid) * 128 + 64, 128, 64, F.lane);
        VState<3> st;
#pragma unroll
        for (int p = 0; p < 3; ++p) { st.m[p] = 0.f; st.l[p] = 0.125f; st.o[p] = o[p]; }
        otot += gate0 * valu_combine<3>(st, scr, F.wid, F.lane);
    }
    if (F.tid < 129) { const int j = F.tid; float im = 0.f;
#pragma unroll
        for (int i = -1; i < 4; ++i) { const int n = 4 * j + i; if (n >= 0 && n < 512) im += P3[n]; }
        scl[j] = im + ((j == 0 || j >= 127) ? 1e4f : 0.f); }
    __syncthreads();
    if (F.tid < 129) { const int j = F.tid; const float sj = scl[j]; int rank = 0;
        for (int k = 0; k < 129; ++k) { const float v = scl[k]; rank += ((v > sj) || (v == sj && k < j)) ? 1 : 0; }
        if (rank < 16) slist[rank] = j; }
    __syncthreads();
    {
        VState<3> st; st.init();
#pragma unroll 1
        for (int e = 0; e < 2; ++e) {
            const int j = slist[F.wid + 8 * e];
            if (j < 128) {
                const size_t prow = (size_t)F.page_table()[b * NPG + (j >> 1)] * 128 + (j & 1) * 64;
                const float* base = F.cache_slc() + (prow * 2) * 256 + g * 64;
                valu_block<3>(st, qs, base + (size_t)F.lane * 512, true, base + 256, 512, 64, F.lane);
            } else {
                const float* base = F.out + O_SLC_S + ((size_t)(b * 4) * 2) * 256 + g * 64;
                const bool valid = F.lane <= tt;
                valu_block<3>(st, qs, base + (size_t)(valid ? F.lane : 0) * 512, valid, base + 256, 512, 4, F.lane);
            }
        }
        otot += gate1 * valu_combine<3>(st, scr, F.wid, F.lane);
    }
    {
        VState<3> st; st.init();
        {
            const int idx = 64 * F.wid + F.lane; const bool valid = idx >= tt + 1;
            const float* base = F.cache_win() + ((size_t)(b * 512 + 64 * F.wid) * 2) * 256 + g * 64;
            valu_block<3>(st, qs, base + (size_t)F.lane * 512, valid, base + 256, 512, 64, F.lane);
        }
        if (F.wid == 0) {
            const float* base = F.out + O_WIN_S + ((size_t)(b * 512 + 508) * 2) * 256 + g * 64;
            const bool valid = F.lane <= tt;
            valu_block<3>(st, qs, base + (size_t)(valid ? F.lane : 0) * 512, valid, base + 256, 512, 4, F.lane);
        }
        otot += gate2 * valu_combine<3>(st, scr, F.wid, F.lane);
    }
    if (F.wid < 3) F.CAT()[(size_t)row * D + (3 * g + F.wid) * 64 + F.lane] = (bf16)(pk2(otot, 0.f) & 0xffffu);
}
constexpr int CMP_A_BYTES = 132 * 144, CMP_B_BYTES = 128 * 144;
__device__ __forceinline__ void compress_unit(Frame& F, bool samp, int b, int n0, int nb) {
    const int lane = F.lane, wid = F.wid, tid = F.tid, fr = lane & 15, fq = lane >> 4;
    const int c = wid >> 2, wm = (wid >> 1) & 1, wn = wid & 1;
    const float* src = samp ? F.cache_cmp() : F.out + O_CMP_P;
    const int* pt = F.page_table();
    const int npos = samp ? PAST : SP;
    const bf16* W1 = F.W_PHI1T();
    f32x4 acc[4][4];
#pragma unroll
    for (int i = 0; i < 4; ++i)
#pragma unroll
        for (int j = 0; j < 4; ++j) acc[i][j] = (f32x4){0.f, 0.f, 0.f, 0.f};
    f32x4 ar[9]; u32x4 br[8];
    long long rbase[9];
#pragma unroll
    for (int i = 0; i < 9; ++i) { const int q = tid + 512 * i, x = q >> 7, cq = q & 127, pos0 = 16 * (n0 + x);
        if (x <= nb && x < 33 && pos0 < npos) { const size_t prow = samp ? (size_t)pt[b * NPG + (pos0 >> 7)] * 128 + (pos0 & 127) : (size_t)b * SP + pos0; rbase[i] = (long long)(prow * 512 + 4 * cq); }
        else rbase[i] = -1; }
    auto issue = [&](int jj) {
#pragma unroll
        for (int i = 0; i < 8; ++i) { const int q = tid + 512 * i, js = q >> 11; br[i] = *(const u32x4*)(W1 + (size_t)((q >> 3) & 255) * 2048 + (jj + 16 * js) * 64 + 8 * (q & 7)); }
#pragma unroll
        for (int i = 0; i < 9; ++i) { if (rbase[i] >= 0) ar[i] = *(const f32x4*)(src + rbase[i] + (size_t)jj * 512); else ar[i] = (f32x4){0.f, 0.f, 0.f, 0.f}; }
    };
    LAS unsigned char* sA = F.lds; LAS unsigned char* sB = F.lds + 2 * CMP_A_BYTES;
    auto stash = [&]() {
#pragma unroll
        for (int i = 0; i < 9; ++i) { const int q = tid + 512 * i, x = q >> 7, cq = q & 127, cc = cq >> 6, hh = (cq >> 4) & 3, d = 4 * (cq & 15);
            if (x < 33) *(LAS u32x2*)(sA + cc * CMP_A_BYTES + (x * 4 + hh) * 144 + d * 2) = pk4(ar[i]); }
#pragma unroll
        for (int i = 0; i < 8; ++i) { const int q = tid + 512 * i; *(LAS u32x4*)(sB + (q >> 3) * 144 + 16 * (q & 7)) = br[i]; }
    };
    const int rot = (b + (n0 >> 4)) & 15;
    issue(rot); stash(); __syncthreads();
    for (int jj = 0; jj < 16; ++jj) {
        if (jj + 1 < 16) issue((jj + 1 + rot) & 15);
        if (wm * 16 < nb) {
#pragma unroll
            for (int js = 0; js < 2; ++js) {
                const LAS unsigned char* ap = sA + c * CMP_A_BYTES + (wm * 64 + fr + 4 * js) * 144 + 16 * fq;
                const LAS unsigned char* bp = sB + (js * 2 + c) * CMP_B_BYTES + (wn * 64 + fr) * 144 + 16 * fq;
#pragma unroll
                for (int kc = 0; kc < 2; ++kc) {
                    bf16x8 af[4], bf_[4];
#pragma unroll
                    for (int i = 0; i < 4; ++i) { af[i] = *(const LAS bf16x8*)(ap + i * 16 * 144 + kc * 64); bf_[i] = *(const LAS bf16x8*)(bp + i * 16 * 144 + kc * 64); }
#pragma unroll
                    for (int i = 0; i < 4; ++i)
#pragma unroll
                        for (int j = 0; j < 4; ++j) acc[i][j] = MFMA16(bf_[j], af[i], acc[i][j]);
                }
            }
        }
        __syncthreads();
        if (jj + 1 < 16) stash();
        __syncthreads();
    }
    LAS bf16* Hs = (LAS bf16*)F.lds + c * 128 * 136;
    { const float* peb = F.PEB() + c * 128;
#pragma unroll
      for (int j = 0; j < 4; ++j) { const int e0 = wn * 64 + 16 * j + 4 * fq; const f32x4 pe = *(const f32x4*)(peb + e0);
#pragma unroll
        for (int i = 0; i < 4; ++i) { f32x4 h;
#pragma unroll
            for (int k = 0; k < 4; ++k) h[k] = gelu_t(acc[i][j][k] + pe[k]);
            *(LAS u32x2*)(Hs + (wm * 64 + 16 * i + fr) * 136 + e0) = pk4(h); } } }
    __syncthreads();
    const int wq = wid & 3;
    f32x4 o2[2][4];
#pragma unroll
    for (int i = 0; i < 2; ++i)
#pragma unroll
        for (int j = 0; j < 4; ++j) o2[i][j] = (f32x4){0.f, 0.f, 0.f, 0.f};
    const bf16* W2 = F.W_PHI2T() + (size_t)c * 64 * 128;
#pragma unroll
    for (int ks = 0; ks < 4; ++ks) {
        bf16x8 hf[2], wf[4];
#pragma unroll
        for (int i = 0; i < 2; ++i) hf[i] = *(const LAS bf16x8*)(Hs + (32 * wq + 16 * i + fr) * 136 + 32 * ks + 8 * fq);
#pragma unroll
        for (int j = 0; j < 4; ++j) wf[j] = *(const bf16x8*)(W2 + (size_t)(16 * j + fr) * 128 + 32 * ks + 8 * fq);
#pragma unroll
        for (int i = 0; i < 2; ++i)
#pragma unroll
            for (int j = 0; j < 4; ++j) o2[i][j] = MFMA16(wf[j], hf[i], o2[i][j]);
    }
#pragma unroll
    for (int i = 0; i < 2; ++i) {
        const int m = 32 * wq + 16 * i + fr, nl = m >> 2, hh = m & 3, n_ = n0 + nl;
        if (nl < nb) {
            if (samp) {
#pragma unroll
                for (int j = 0; j < 4; ++j) *(f32x4*)(F.KVCS() + (((size_t)(b * 4 + hh) * 512 + n_) * 2 + c) * 64 + 16 * j + 4 * fq) = o2[i][j];
            } else if (n_ < 255) {
#pragma unroll
                for (int j = 0; j < 4; ++j) { const int d = 16 * j + 4 * fq; const u32x2 w = pk4(o2[i][j]);
                    if (c == 0) *(u32x2*)(F.KCMP() + ((size_t)(b * 4 + hh) * 256 + n_) * 64 + d) = w;
                    else { bf16* p = F.VTCMP() + ((size_t)(b * 4 + hh) * 64 + d) * 256 + n_; p[0] = (bf16)(w.x & 0xffffu); p[256] = (bf16)(w.x >> 16); p[512] = (bf16)(w.y & 0xffffu); p[768] = (bf16)(w.y >> 16); } }
            }
        }
    }
    __syncthreads();
}

struct Args { const void* in[27]; float* out; unsigned char* ws; int ph_lo, ph_hi, use_bar, pad; };
constexpr int CW_BAR = 4096;

template <class F_> __device__ __forceinline__ void big_gemm(Frame& F, const bf16* A, const bf16* Bt, int N, int K, const F_& f) {
    pg8::Gemm g{A, Bt, MP, N, K}; pg8::StaticOrder S; S.init(MP, N, F.G, F.bid);
    EpiElem<F_> E{f};
    pg8::gemm_phase<EpiElem<F_>, pg8::StaticOrder, true, true>(F.lds, g, S, E, F.tid);
}
template <class F_> __device__ __forceinline__ void small_gemm(Frame& F, const bf16* A, int lda, const bf16* Bt, int N, int K, int ksplit, int row0, const F_& f) {
    const int ntn = N / 128, nun = ntn * ksplit, kc = K / ksplit;
    for (int u = F.G - 1 - F.bid; u < nun; u += F.G) { const int tn = u % ntn, ks = u / ntn; sgemm_tile(F.tid, ALoadBf16{A, lda}, Bt, K, ks * kc, (ks + 1) * kc, row0, tn * 128, f); }
}

__device__ __forceinline__ void slab_gemm(Frame& F, const bf16* A, int lda, const bf16* Bt, int N, int K, int ksplit) {
    const int ntn = N / 128, nun = ntn * ksplit, kc = K / ksplit;
    for (int u = F.G - 1 - F.bid; u < nun; u += F.G) { const int tn = u % ntn, ks = u / ntn; sgemm_tile(F.tid, ALoadBf16{A, lda}, Bt, K, ks * kc, (ks + 1) * kc, MP, tn * 128, FSlab{F.ZS() + (size_t)ks * MS * D}); }
}

__global__ void __launch_bounds__(512, 2) yoco_fwd(Args args) {
    extern __shared__ __attribute__((aligned(16))) unsigned char lds_raw[];
    Frame F;
    F.lds = (LAS unsigned char*)lds_raw; F.tid = threadIdx.x; F.lane = F.tid & 63; F.wid = __builtin_amdgcn_readfirstlane(F.tid >> 6); F.G = gridDim.x; F.bid = blockIdx.x;
    F.out = args.out; F.ws = args.ws;
    unsigned char* ws = args.ws;
    volatile LAS unsigned* MISC = (volatile LAS unsigned*)(F.lds + MISC_OFF);
    for (int u = F.tid; u < (LDS_BYTES - CTRL_OFF) / 4; u += 512) ((LAS unsigned*)(F.lds + CTRL_OFF))[u] = 0u;
    __syncthreads();
    if (F.tid == 0) { LAS unsigned long long* ip = (LAS unsigned long long*)(F.lds + INPTR_OFF);
#pragma unroll
        for (int i = 0; i < 27; ++i) ip[i] = (unsigned long long)args.in[i]; }
    __syncthreads();
    XcdBarrier bar; bar.bar = (unsigned*)(ws + WS_CTL) + CW_BAR; bar.x = 0; bar.st = nullptr;
    if (args.use_bar) bar = xcd_barrier_post((unsigned*)(ws + WS_CTL) + CW_BAR, MISC + 8);
    const int lo = args.ph_lo, hi = args.ph_hi; int pc = 0;
#ifndef PROBE_REP
#define PROBE_REP 0
#endif
#define REPEAT(bit) for (int rep_ = 0; rep_ < (((PROBE_REP) >> (bit)) & 1) + 1; ++rep_) if (([&]() { LAUNDER_ALL(); })(), true)
#define RELANE(F) do { int t_ = threadIdx.x; asm volatile("" : "+v"(t_)); F.tid = t_; F.lane = t_ & 63; F.wid = __builtin_amdgcn_readfirstlane(t_ >> 6); } while (0)
#define LAUNDER_ALL() do { int t_ = threadIdx.x; asm volatile("" : "+v"(t_)); F.tid = t_; F.lane = t_ & 63; F.wid = __builtin_amdgcn_readfirstlane(t_ >> 6); \
      int b_ = blockIdx.x; asm volatile("" : "+s"(b_)); F.bid = b_; unsigned char* w_ = args.ws; asm volatile("" : "+s"(w_)); F.ws = w_; float* o_ = args.out; asm volatile("" : "+s"(o_)); F.out = o_; } while (0)
#define PHASE_BEGIN if (lo <= pc && pc < hi) { LAUNDER_ALL();
#define PHASE_END   if (pc + 1 < hi && args.use_bar) xcd_barrier(bar); } ++pc;

    PHASE_BEGIN REPEAT(0) p_prologue(F); PHASE_END
    for (int l = 0; l < 4; ++l) {
        const bool isA = l < 2; const int li = l & 1;
        PHASE_BEGIN
        REPEAT(1)
        if (isA) {
            FInA f{F.U(), F.VP(), F.QM()};
            big_gemm(F, F.XB(), F.W_INA() + (size_t)li * NIA * D, NIA, D, f);
            small_gemm(F, F.XB(), D, F.W_INA() + (size_t)li * NIA * D, NIA, D, 1, MP, f);
            if (l == 0) {
                FMemKV fm{F.out + O_MEM_P, F.KMEM(), F.VTMEM()};
                struct ALoadF32 { const float* A; __device__ __forceinline__ bf16x8 operator()(int row, int k) const { const float* p = A + (size_t)row * D + k; return pk8(*(const f32x4*)p, *(const f32x4*)(p + 4)); } };
                for (int u = F.bid; u < 8 * 16; u += F.G) sgemm_tile(F.tid, ALoadF32{F.mem_prompt()}, F.W_MEM(), D, 0, D, (u & 7) * 128, (u >> 3) * 128, fm);
            }
        } else {
            FInB f{F.ROPE(), F.QB(), F.QM(), F.GT()};
            big_gemm(F, F.XB(), F.W_INB() + (size_t)li * NIBP * D, NIBP, D, f);
            small_gemm(F, F.XB(), D, F.W_INB() + (size_t)li * NIBP * D, NIBP, D, 1, MP, f);
            if (l == 2) {
                FKV fk{F.ROPE(), F.out, F.KSLC(), F.VTSLC(), F.KWIN(), F.VTWIN(), O_CMP_P, O_SLC_P, O_WIN_P, O_CMP_S, O_SLC_S, O_WIN_S};
                big_gemm(F, F.XB(), F.W_KV(), NKV, D, fk);
                small_gemm(F, F.XB(), D, F.W_KV(), NKV, D, 1, MP, fk);
            }
        }
        PHASE_END
        if (l == 2) {
            PHASE_BEGIN
            REPEAT(2)
            for (int u = F.bid; u < 512 + 64; u += F.G) { RELANE(F); if (u < 512) compress_unit(F, true, u >> 4, (u & 15) * 32, 32); else { const int v = u - 512; compress_unit(F, false, v >> 4, (v & 15) * 16, 16); } }
            PHASE_END
        }
        PHASE_BEGIN
        if (isA) {
            REPEAT(3)
            for (int u = F.bid; u < 640 + 512 + 128; u += F.G) {
                RELANE(F);
                if (u < 640) spatial_unit(F, l, u); else if (u < 1152) mem_prompt_unit(F, l, u - 640); else mem_sample_task(F, l, u - 1152);
            }
        } else {
            for (int rep_ = 0; rep_ < ((PROBE_REP & (16 | 512 | 1024 | 2048)) ? 2 : 1); ++rep_)
            for (int u = F.bid; u < 512 + 512 + 512 + 128; u += F.G) {
                LAUNDER_ALL();
                const int ty_ = u < 512 ? 0 : (u < 1024 ? 1 : 2);
                if (rep_ > 0 && !((PROBE_REP >> 4) & 1) && !((PROBE_REP >> (9 + ty_)) & 1)) continue;
                if (u < 512) { const int c_ = u & 255, x_ = c_ & 7, j_ = c_ >> 3; nsa_prompt_unit(F, 2 * x_ + (j_ & 1), u < 256 ? 31 - (j_ >> 1) : (j_ >> 1)); } else if (u < 1024) nsa_sample_task(F, u - 512); else if (u < 1536) mem_prompt_unit(F, l, u - 1024); else mem_sample_task(F, l, u - 1536);
            }
        }
        PHASE_END
        PHASE_BEGIN
        REPEAT(5)
        { const bf16* W = (isA ? F.W_OUTA() : F.W_OUTB()) + (size_t)li * D * D;
          big_gemm(F, F.CAT(), W, D, D, FRes{F.XRES(), F.Z()});
          slab_gemm(F, F.CAT(), D, W, D, D, 4);
        }
        PHASE_END
        PHASE_BEGIN ln_pass(F, F.ln1_g() + l * D, F.ln1_b() + l * D, 4, F.XRES(), F.XRES() + (size_t)MP * D, F.XB());
        if ((PROBE_REP >> 6) & 1) ln_pass(F, F.ln1_g() + l * D, F.ln1_b() + l * D, 4, F.XRES(), F.XRES() + (size_t)MP * D, F.XB(), MP); PHASE_END
        PHASE_BEGIN
        REPEAT(7)
        { FUp f{F.HB()}; big_gemm(F, F.XB(), F.W_UP() + (size_t)l * FF * D, FF, D, f); small_gemm(F, F.XB(), D, F.W_UP() + (size_t)l * FF * D, FF, D, 1, MP, f); }
        PHASE_END
        PHASE_BEGIN
        REPEAT(8)
        { const bf16* W = F.W_DOWN() + (size_t)l * D * FF;
          big_gemm(F, F.HB(), W, D, FF, FRes{F.XRES(), F.Z()});
          slab_gemm(F, F.HB(), FF, W, D, FF, 8); }
        PHASE_END
        PHASE_BEGIN
        if (l < 3) ln_pass(F, F.ln2_g() + l * D, F.ln2_b() + l * D, 8, F.XRES(), F.XRES() + (size_t)MP * D, F.XB());
        else       ln_pass(F, F.ln2_g() + l * D, F.ln2_b() + l * D, 8, F.out + O_Y_P, F.out + O_Y_S, nullptr);
        if ((PROBE_REP >> 6) & 1) { if (l < 3) ln_pass(F, F.ln2_g() + l * D, F.ln2_b() + l * D, 8, F.XRES(), F.XRES() + (size_t)MP * D, F.XB(), MP); else ln_pass(F, F.ln2_g() + l * D, F.ln2_b() + l * D, 8, F.out + O_Y_P, F.out + O_Y_S, nullptr, MP); }
        PHASE_END
    }
}

constexpr int NPHASES = 1 + 4 * 7 + 1;
static_assert(O_END == 45547520, "output size");
#ifndef MK_PER_PHASE
#define MK_PER_PHASE 0
#endif
extern "C" void kernel_launch(void* const* d_in, const int* in_sizes, int n_in, void* d_out, int out_size, void* d_ws, size_t ws_size, hipStream_t stream) {
    static int grid = 0;
    if (grid == 0) {
        if (n_in != 27 || (size_t)out_size != O_END || ws_size < WS_END) { fprintf(stderr, "kernel_launch: unexpected shapes (n_in %d, out %d, ws %zu; need 27, %zu, >= %zu)\n", n_in, out_size, ws_size, (size_t)O_END, (size_t)WS_END); grid = -1; return; }
        int dev = 0, cus = 0, per_cu = 0;
        if (hipGetDevice(&dev) != hipSuccess || hipDeviceGetAttribute(&cus, hipDeviceAttributeMultiprocessorCount, dev) != hipSuccess) { grid = -1; return; }
        if (hipFuncSetAttribute((const void*)yoco_fwd, hipFuncAttributeMaxDynamicSharedMemorySize, LDS_BYTES) != hipSuccess) { fprintf(stderr, "kernel_launch: hipFuncSetAttribute failed\n"); grid = -1; return; }
        if (hipOccupancyMaxActiveBlocksPerMultiprocessor(&per_cu, (const void*)yoco_fwd, 512, LDS_BYTES) != hipSuccess || per_cu < 1) { fprintf(stderr, "kernel_launch: occupancy query says %d blocks per CU\n", per_cu); (void)hipGetLastError(); }
        grid = cus;
    }
    if (grid < 0) return;
    (void)hipMemsetAsync((char*)d_ws + WS_CTL, 0, CTL_BYTES, stream);
    Args a{};
    for (int i = 0; i < 27; ++i) a.in[i] = d_in[i];
    a.out = (float*)d_out; a.ws = (unsigned char*)d_ws; a.pad = 0;
#if MK_PER_PHASE
    for (int p = 0; p < NPHASES; ++p) { a.ph_lo = p; a.ph_hi = p + 1; a.use_bar = 0; hipLaunchKernelGGL(yoco_fwd, dim3(grid), dim3(512), LDS_BYTES, stream, a); }
#else
    a.ph_lo = 0; a.ph_hi = NPHASES; a.use_bar = 1;
    hipLaunchKernelGGL(yoco_fwd, dim3(grid), dim3(512), LDS_BYTES, stream, a);
#endif
    const hipError_t le = hipPeekAtLastError();
    if (le != hipSuccess) fprintf(stderr, "kernel_launch: launch failed: %s\n", hipGetErrorName(le));
}
```
